# Optimizing an MI355X kernel written in HIP

```python
import jax, jax.numpy as jnp
from jax import lax
import numpy as np

D_MODEL = 1024
BATCH = 8
SEQ = 2048
DEPTH = 1
DEC_BATCH = 8
DEC_SEQ = 64
PAST_LEN = 4096

CHUNK = 64
D_MIX = D_MODEL
D_CONV = D_MIX // 2
D_ATT = D_MIX - D_CONV
HEAD_DIM = 64
N_HEADS = D_ATT // HEAD_DIM
CONV_WIDTH = 31
LEFT_CHUNKS = 8
BAND = (LEFT_CHUNKS + 1) * CHUNK
MAX_REL = 128
D_FF = 4 * D_MODEL
D_PLE = 256
D_IN = 2 * D_CONV + 3 * D_ATT
EPS = 1e-6
NEG = -1e30

kernel_name = "hymba_conv_chunkband_attn_stream_step"


def rms_norm(x, g):
    xf = x.astype(jnp.float32)
    y = xf * lax.rsqrt(jnp.mean(xf * xf, axis=-1, keepdims=True) + EPS)
    return (y * g.astype(jnp.float32)).astype(x.dtype)


def layer_norm(x, g, b):
    xf = x.astype(jnp.float32)
    mu = jnp.mean(xf, axis=-1, keepdims=True)
    var = jnp.mean(jnp.square(xf - mu), axis=-1, keepdims=True)
    y = (xf - mu) * lax.rsqrt(var + EPS)
    return (y * g.astype(jnp.float32) + b.astype(jnp.float32)).astype(x.dtype)


def in_proj(x, g_mix, w_in, g_q, g_k):
    z = rms_norm(x, g_mix) @ w_in
    b, t, _ = z.shape
    a = z[..., :D_CONV]
    gate = z[..., D_CONV:2 * D_CONV]
    u = a * jax.nn.sigmoid(gate)
    o = 2 * D_CONV
    q = z[..., o:o + D_ATT].reshape(b, t, N_HEADS, HEAD_DIM)
    k = z[..., o + D_ATT:o + 2 * D_ATT].reshape(b, t, N_HEADS, HEAD_DIM)
    v = z[..., o + 2 * D_ATT:].reshape(b, t, N_HEADS, HEAD_DIM)
    return u, rms_norm(q, g_q), rms_norm(k, g_k), v


def conv_branch(u_full, w_dw, b_dw, g_ln, b_ln):
    y = lax.conv_general_dilated(
        u_full, w_dw[:, None, :], window_strides=(1,), padding='VALID',
        dimension_numbers=('NWC', 'WIO', 'NWC'), feature_group_count=D_CONV)
    y = layer_norm(y + b_dw, g_ln, b_ln)
    return jax.nn.silu(y)


def bias_lookup(rel_bias, rel):
    idx = jnp.clip(rel, -MAX_REL, MAX_REL) + MAX_REL
    return rel_bias[:, idx].astype(jnp.float32)


def chunk_attn_prompt(q, k, v, rel_bias):
    b, t, h, dh = q.shape
    nc = t // CHUNK
    qc = q.reshape(b, nc, CHUNK, h, dh)
    pad = ((0, 0), (LEFT_CHUNKS, 0), (0, 0), (0, 0), (0, 0))
    kp = jnp.pad(k.reshape(b, nc, CHUNK, h, dh), pad)
    vp = jnp.pad(v.reshape(b, nc, CHUNK, h, dh), pad)
    kb = jnp.concatenate([kp[:, o:o + nc] for o in range(LEFT_CHUNKS + 1)], axis=2)
    vb = jnp.concatenate([vp[:, o:o + nc] for o in range(LEFT_CHUNKS + 1)], axis=2)
    s = jnp.einsum('bnqhd,bnkhd->bnhqk', qc, kb).astype(jnp.float32) * (HEAD_DIM ** -0.5)
    qi = jnp.arange(CHUNK)
    kk = jnp.arange(BAND)
    rel = kk[None, :] - LEFT_CHUNKS * CHUNK - qi[:, None]
    s = s + bias_lookup(rel_bias, rel)[None, None]
    kpos = (jnp.arange(nc)[:, None] - LEFT_CHUNKS) * CHUNK + kk[None, :]
    s = jnp.where((kpos >= 0)[None, :, None, None, :], s, NEG)
    p = jax.nn.softmax(s, axis=-1).astype(v.dtype)
    o = jnp.einsum('bnhqk,bnkhd->bnqhd', p, vb)
    return o.reshape(b, t, h * dh)


def chunk_attn_sample(q, k_new, v_new, k_cache, v_cache, rel_bias):
    b, s_len, h, dh = q.shape
    l = k_cache.shape[1]
    kk = jnp.concatenate([k_cache, k_new], axis=1)
    vv = jnp.concatenate([v_cache, v_new], axis=1)
    s = jnp.einsum('bqhd,bkhd->bhqk', q, kk).astype(jnp.float32) * (HEAD_DIM ** -0.5)
    kpos = jnp.concatenate([jnp.arange(l) - l, jnp.arange(s_len)])
    rel = kpos[None, :] - jnp.arange(s_len)[:, None]
    s = s + bias_lookup(rel_bias, rel)[None]
    p = jax.nn.softmax(s, axis=-1).astype(vv.dtype)
    o = jnp.einsum('bhqk,bkhd->bqhd', p, vv)
    return o.reshape(b, s_len, h * dh)


def merge_ffn_ple(x, p, c_out, a_out, g_conv_out, g_att_out, w_out, g_ffn, w_ff1, w_ff2,
                  g_ple, w_gate, w_ple):
    merged = jnp.concatenate([rms_norm(c_out, g_conv_out), rms_norm(a_out, g_att_out)], axis=-1)
    x = x + merged @ w_out
    h = rms_norm(x, g_ffn)
    x = x + jnp.square(jax.nn.relu(h @ w_ff1)) @ w_ff2
    gate = jax.nn.sigmoid(rms_norm(x, g_ple) @ w_gate)
    return x + (p @ w_ple) * gate


def setup_inputs(seed: int = 0) -> dict:
    key = jax.random.key(seed)
    ks = jax.random.split(key, 32)
    f32 = jnp.float32
    att_len = min(LEFT_CHUNKS * CHUNK, PAST_LEN)

    def nrm(k, shape, scale):
        return jax.random.normal(k, shape, f32) * scale

    def gain(k, shape):
        return 1.0 + 0.01 * jax.random.normal(k, shape, f32)

    return {
        "x_prompt": nrm(ks[0], (BATCH, SEQ, D_MODEL), 1.0),
        "x_sample": nrm(ks[1], (DEC_BATCH, DEC_SEQ, D_MODEL), 1.0),
        "p_prompt": nrm(ks[2], (DEPTH, BATCH, SEQ, D_PLE), 1.0),
        "p_sample": nrm(ks[3], (DEPTH, DEC_BATCH, DEC_SEQ, D_PLE), 1.0),
        "cache_att_k": nrm(ks[4], (DEPTH, DEC_BATCH, att_len, N_HEADS, HEAD_DIM), 1.0),
        "cache_att_v": nrm(ks[5], (DEPTH, DEC_BATCH, att_len, N_HEADS, HEAD_DIM), 1.0),
        "state_conv": nrm(ks[6], (DEPTH, DEC_BATCH, CONV_WIDTH - 1, D_CONV), 0.5),
        "g_mix": gain(ks[7], (DEPTH, D_MODEL)),
        "w_in": nrm(ks[8], (DEPTH, D_MODEL, D_IN), D_MODEL ** -0.5),
        "w_dw": nrm(ks[9], (DEPTH, CONV_WIDTH, D_CONV), CONV_WIDTH ** -0.5),
        "b_dw": nrm(ks[10], (DEPTH, D_CONV), 0.01),
        "g_conv_ln": gain(ks[11], (DEPTH, D_CONV)),
        "b_conv_ln": nrm(ks[12], (DEPTH, D_CONV), 0.01),
        "g_q": gain(ks[13], (DEPTH, HEAD_DIM)),
        "g_k": gain(ks[14], (DEPTH, HEAD_DIM)),
        "rel_bias": nrm(ks[15], (DEPTH, N_HEADS, 2 * MAX_REL + 1), 0.1),
        "g_conv_out": gain(ks[16], (DEPTH, D_CONV)),
        "g_att_out": gain(ks[17], (DEPTH, D_ATT)),
        "w_out": nrm(ks[18], (DEPTH, D_MIX, D_MODEL), D_MIX ** -0.5),
        "g_ffn": gain(ks[19], (DEPTH, D_MODEL)),
        "w_ff1": nrm(ks[20], (DEPTH, D_MODEL, D_FF), D_MODEL ** -0.5),
        "w_ff2": nrm(ks[21], (DEPTH, D_FF, D_MODEL), D_FF ** -0.5),
        "g_ple": gain(ks[22], (DEPTH, D_MODEL)),
        "w_gate": nrm(ks[23], (DEPTH, D_MODEL, D_MODEL), D_MODEL ** -0.5),
        "w_ple": nrm(ks[24], (DEPTH, D_PLE, D_MODEL), D_PLE ** -0.5),
    }


def reference(x_prompt, x_sample, p_prompt, p_sample, cache_att_k, cache_att_v, state_conv,
              g_mix, w_in, w_dw, b_dw, g_conv_ln, b_conv_ln, g_q, g_k, rel_bias,
              g_conv_out, g_att_out, w_out, g_ffn, w_ff1, w_ff2, g_ple, w_gate, w_ple):
    xp, xs = x_prompt, x_sample
    kp_l, vp_l, cp_l, ks_l, vs_l, cs_l = [], [], [], [], [], []
    for i in range(DEPTH):
        u_p, q_p, k_p, v_p = in_proj(xp, g_mix[i], w_in[i], g_q[i], g_k[i])
        c_p = conv_branch(jnp.pad(u_p, ((0, 0), (CONV_WIDTH - 1, 0), (0, 0))),
                          w_dw[i], b_dw[i], g_conv_ln[i], b_conv_ln[i])
        a_p = chunk_attn_prompt(q_p, k_p, v_p, rel_bias[i])
        keep = min(LEFT_CHUNKS * CHUNK, xp.shape[1])
        kp_l.append(k_p[:, -keep:])
        vp_l.append(v_p[:, -keep:])
        cp_l.append(u_p[:, -(CONV_WIDTH - 1):])
        xp = merge_ffn_ple(xp, p_prompt[i], c_p, a_p, g_conv_out[i], g_att_out[i], w_out[i],
                           g_ffn[i], w_ff1[i], w_ff2[i], g_ple[i], w_gate[i], w_ple[i])
        u_s, q_s, k_s, v_s = in_proj(xs, g_mix[i], w_in[i], g_q[i], g_k[i])
        conv_in = jnp.concatenate([state_conv[i], u_s], axis=1)
        c_s = conv_branch(conv_in, w_dw[i], b_dw[i], g_conv_ln[i], b_conv_ln[i])
        a_s = chunk_attn_sample(q_s, k_s, v_s, cache_att_k[i], cache_att_v[i], rel_bias[i])
        ks_l.append(k_s)
        vs_l.append(v_s)
        cs_l.append(conv_in[:, -(CONV_WIDTH - 1):])
        xs = merge_ffn_ple(xs, p_sample[i], c_s, a_s, g_conv_out[i], g_att_out[i], w_out[i],
                           g_ffn[i], w_ff1[i], w_ff2[i], g_ple[i], w_gate[i], w_ple[i])
    new_k_prompt = jnp.stack(kp_l)
    new_v_prompt = jnp.stack(vp_l)
    new_conv_prompt = jnp.stack(cp_l)
    new_k_sample = jnp.stack(ks_l)
    new_v_sample = jnp.stack(vs_l)
    new_conv_sample = jnp.stack(cs_l)
    return (xp, xs, new_k_prompt, new_v_prompt, new_conv_prompt, new_k_sample, new_v_sample, new_conv_sample)
```

```cpp
#include <hip/hip_runtime.h>
#include <cstdio>
#include <cstdint>

#define DI __device__ __forceinline__
#define LAS __attribute__((address_space(3)))
#define GAS __attribute__((address_space(1)))
typedef unsigned short bf16;
typedef short bf16x8 __attribute__((ext_vector_type(8)));
typedef float f32x4 __attribute__((ext_vector_type(4)));
typedef float f32x2 __attribute__((ext_vector_type(2)));
typedef float f32x16 __attribute__((ext_vector_type(16)));
typedef unsigned u32x4 __attribute__((ext_vector_type(4)));
typedef unsigned u32x2 __attribute__((ext_vector_type(2)));
typedef __bf16 bf16x2_t __attribute__((ext_vector_type(2)));
typedef GAS unsigned gu32;

constexpr int DM = 1024, NB = 8, SEQ = 2048, DSEQ = 64, DCONV = 512, DATT = 512, NH = 8, HD = 64, CW = 31, DFF = 4096, DPLE = 256, DIN = 2560;
constexpr int RP = NB * SEQ, RS = NB * DSEQ, R = RP + RS;
constexpr int KEEP = 512, CST = CW - 1;
constexpr float EPS = 1e-6f;
constexpr float LOG2E = 1.4426950408889634f;
constexpr float C2 = 0.125f * LOG2E;
constexpr size_t O_YP = 0, O_YS = (size_t)RP * DM, O_KP = O_YS + (size_t)RS * DM, O_VP = O_KP + (size_t)NB * KEEP * DATT, O_CP = O_VP + (size_t)NB * KEEP * DATT,
                 O_KS = O_CP + (size_t)NB * CST * DCONV, O_VS = O_KS + (size_t)RS * DATT, O_CS = O_VS + (size_t)RS * DATT, O_END = O_CS + (size_t)NB * CST * DCONV;
constexpr size_t MiB = 1u << 20;
constexpr size_t WS_CTL = 0, CTL_ZERO_BYTES = 64 * 1024;
constexpr size_t WS_RMIX = 1 * MiB;
constexpr size_t WS_SSQA = WS_RMIX + 128 * 1024;
constexpr size_t WS_SSQ1 = 2 * MiB;
constexpr size_t WS_SSQ2 = 4 * MiB;
constexpr size_t WS_WIN = 6 * MiB, WS_WOUT = 11 * MiB, WS_W1 = 13 * MiB, WS_W2 = 21 * MiB, WS_WGP = 29 * MiB;
constexpr size_t WS_ACAT = 32 * MiB;
constexpr size_t WS_X1B = 74 * MiB;
constexpr size_t WS_KC = WS_X1B, WS_VCT = WS_X1B + 4 * MiB, WS_VTS = WS_X1B + 8 * MiB, WS_PLE = WS_X1B;
constexpr size_t WS_H = 107 * MiB;
constexpr size_t WS_XB = WS_H, WS_UB = WS_XB + 33 * MiB, WS_QB = WS_UB + 33 * MiB / 2, WS_KB = WS_QB + 33 * MiB / 2, WS_VTP = WS_KB + 33 * MiB / 2, WS_MRG = WS_VTP + 16 * MiB;
constexpr size_t WS_END = 256 * MiB;
static_assert(WS_MRG + (size_t)R * DM * 2 <= WS_H + (size_t)R * DFF * 2 && WS_H + (size_t)R * DFF * 2 <= WS_END, "d_ws map");
static_assert(WS_ACAT + (size_t)R * 1280 * 2 <= WS_X1B && WS_X1B + (size_t)R * DM * 2 <= WS_H, "d_ws map 2");
constexpr int CW_BAR = 1024;

DI unsigned cvtpk(float lo, float hi) { f32x2 v = {lo, hi}; bf16x2_t b = __builtin_convertvector(v, bf16x2_t); return __builtin_bit_cast(unsigned, b); }
DI float bf2f(unsigned short h) { return __uint_as_float((unsigned)h << 16); }
DI float sigmoidf_(float x) { return __builtin_amdgcn_rcpf(1.f + __builtin_amdgcn_exp2f(-LOG2E * x)); }
DI float wave_sum(float v) {
#pragma unroll
    for (int o = 1; o < 64; o <<= 1) v += __shfl_xor(v, o);
    return v;
}
#define LDS_WAIT() asm volatile("s_waitcnt lgkmcnt(0)" ::: "memory")
#define VM_WAIT() asm volatile("s_waitcnt vmcnt(0)" ::: "memory")

namespace pg8 {
constexpr int BM = 256, BK = 64, HALF = 128, HTB = HALF * BK * 2, STAGE_BYTES = 8 * HTB;
__host__ __device__ __forceinline__ int lds_byte(int r, int c) { const int st = (r >> 4) * 2 + (c >> 5), rr = r & 15, cc = c & 31, ob = rr * 64 + cc * 2; return st * 1024 + (ob ^ (((ob >> 9) & 1) << 5)); }
__host__ __device__ __forceinline__ void stage_rc(int b, int& R_, int& C) { const int st = b / 1024, sb = b % 1024, swz = sb ^ (((sb >> 9) & 1) << 5); R_ = (st >> 1) * 16 + swz / 64; C = (st & 1) * 32 + (swz % 64) / 2; }
__host__ __device__ __forceinline__ int perm32(int rho) { const int n = rho >> 4, i = rho & 15; return 8 * (i >> 2) + 4 * n + (i & 3); }

struct Unit { const char* A; const char* B; int nt; int kind; int pm; int pn; };

template <class Epi, class Sched, bool ALIGN_EPI>
DI void gemm_phase(LAS unsigned char* lds, const int pitch, const Sched& S, const Epi& E) {
    int tid = threadIdx.x; asm volatile("" : "+v"(tid));
    const int wid = __builtin_amdgcn_readfirstlane(tid >> 6), lane = tid & 63, wr = wid >> 2, wc = wid & 3, fr = lane & 15, fq = lane >> 4;
    unsigned voffA[2], voffB[2];
#pragma unroll
    for (int i = 0; i < 2; ++i) { int R_, C; stage_rc(tid * 16 + i * 8192, R_, C); const int Rb = (R_ & ~31) + perm32(R_ & 31);
        voffA[i] = (unsigned)(R_ * pitch + C) * 2u; voffB[i] = (unsigned)(Rb * pitch + C) * 2u; }
    const size_t kstep = (size_t)(BK * 2);
    const size_t hstep = (size_t)HALF * pitch * 2;
    const unsigned ldsw = (unsigned)wid * 1024u;
    const int aoff = lds_byte(wr * 64 + fr, fq * 8), boff = lds_byte(wc * 32 + fr, fq * 8);
#define PG8_SA(b, h) (((b) * 2 + (h)) * HTB)
#define PG8_SB(b, h) ((4 + (b) * 2 + (h)) * HTB)
#define PG8_STAGE(bufoff, gbase, voff) do { _Pragma("unroll") for (int _i = 0; _i < 2; ++_i) \
        __builtin_amdgcn_global_load_lds((const unsigned*)((const char*)(gbase) + (voff)[_i]), (LAS unsigned*)(lds + (bufoff) + ldsw + _i * 8192), 16, 0, 0); } while (0)
#define PG8_LDA(dst, b, h) do { _Pragma("unroll") for (int m = 0; m < 4; ++m) _Pragma("unroll") for (int k = 0; k < 2; ++k) dst[m][k] = *(const LAS bf16x8*)(lds + PG8_SA(b, h) + aoff + m * 2048 + k * 1024); } while (0)
#define PG8_LDB(dst, b, h) do { _Pragma("unroll") for (int n = 0; n < 2; ++n) _Pragma("unroll") for (int k = 0; k < 2; ++k) dst[n][k] = *(const LAS bf16x8*)(lds + PG8_SB(b, h) + boff + n * 2048 + k * 1024); } while (0)
#define PG8_MMA(ai, bj, At, Bt) do { __builtin_amdgcn_s_setprio(1); _Pragma("unroll") for (int m = 0; m < 4; ++m) _Pragma("unroll") for (int n = 0; n < 2; ++n) _Pragma("unroll") for (int k = 0; k < 2; ++k) \
        acc[ai][bj][m][n] = __builtin_amdgcn_mfma_f32_16x16x32_bf16(Bt[n][k], At[m][k], acc[ai][bj][m][n], 0, 0, 0); __builtin_amdgcn_s_setprio(0); } while (0)
#define PG8_WAIT_V(n) asm volatile("s_waitcnt vmcnt(" #n ")" ::: "memory")
#define PG8_WAIT_L(n) asm volatile("s_waitcnt lgkmcnt(" #n ")" ::: "memory")
#define PG8_BAR __builtin_amdgcn_s_barrier()
#define PG8_SCHED __builtin_amdgcn_sched_barrier(0)
    Unit cur, nxt; int ui = 0;
    if (!S.next(0, cur)) return;
    f32x4 acc[2][2][4][2];
#pragma unroll
    for (int a = 0; a < 2; ++a)
#pragma unroll
        for (int b = 0; b < 2; ++b)
#pragma unroll
            for (int m = 0; m < 4; ++m)
#pragma unroll
                for (int n = 0; n < 2; ++n) acc[a][b][m][n] = (f32x4){0.f, 0.f, 0.f, 0.f};
    bf16x8 At[4][2], B0[2][2], B1[2][2];
    const char* cA = cur.A; const char* cB = cur.B;
    E.a_ready(cur, 0, lds);
    PG8_STAGE(PG8_SB(0, 0), cB, voffB); PG8_STAGE(PG8_SB(0, 1), cB + hstep, voffB); PG8_STAGE(PG8_SA(0, 0), cA, voffA); PG8_STAGE(PG8_SA(0, 1), cA + hstep, voffA);
    if (wr == 1) PG8_BAR;
    PG8_WAIT_V(2); PG8_BAR;
    PG8_STAGE(PG8_SB(1, 0), cB + kstep, voffB); PG8_STAGE(PG8_SA(1, 0), cA + kstep, voffA); PG8_STAGE(PG8_SB(1, 1), cB + hstep + kstep, voffB);
    PG8_WAIT_V(6); PG8_BAR;
    for (;;) {
        const bool has_next = S.next(ui + 1, nxt);
        const char* nA = has_next ? nxt.A : cA; const char* nB = has_next ? nxt.B : cB;
        const int nt = cur.nt;
        for (int t = 0; t < nt; t += 2) {
            const bool last = (t == nt - 2);
            if constexpr (Epi::HAS_MID) { if (t == Epi::MID_T) E.mid(acc, cur, ui, wr, wc, fr, fq, lds); }
            const char* a1 = cA + (size_t)(t + 1) * kstep;
            const char* a2 = last ? nA : cA + (size_t)(t + 2) * kstep; const char* b2 = last ? nB : cB + (size_t)(t + 2) * kstep;
            const char* a3 = a2 + kstep; const char* b3 = b2 + kstep;
            if (last && has_next) E.a_ready(nxt, ui + 1, lds);
            PG8_LDB(B0, 0, 0); PG8_LDB(B1, 0, 1); PG8_SCHED; PG8_LDA(At, 0, 0); PG8_STAGE(PG8_SA(1, 1), a1 + hstep, voffA);
            PG8_WAIT_V(8); PG8_WAIT_L(0); PG8_BAR; PG8_MMA(0, 0, At, B0); PG8_MMA(0, 1, At, B1); PG8_BAR; PG8_SCHED;
            PG8_LDA(At, 0, 1); PG8_STAGE(PG8_SB(0, 0), b2, voffB); PG8_STAGE(PG8_SB(0, 1), b2 + hstep, voffB); PG8_STAGE(PG8_SA(0, 0), a2, voffA);
            PG8_WAIT_V(8); PG8_WAIT_L(0); PG8_BAR; PG8_MMA(1, 0, At, B0); PG8_MMA(1, 1, At, B1); PG8_BAR; PG8_SCHED;
            PG8_LDB(B0, 1, 0); PG8_LDB(B1, 1, 1); PG8_SCHED; PG8_LDA(At, 1, 0); PG8_STAGE(PG8_SA(0, 1), a2 + hstep, voffA);
            PG8_WAIT_V(8); PG8_WAIT_L(0); PG8_BAR; PG8_MMA(0, 0, At, B0); PG8_MMA(0, 1, At, B1); PG8_BAR; PG8_SCHED;
            PG8_LDA(At, 1, 1); PG8_STAGE(PG8_SB(1, 0), b3, voffB); PG8_STAGE(PG8_SB(1, 1), b3 + hstep, voffB); PG8_STAGE(PG8_SA(1, 0), a3, voffA);
            PG8_WAIT_V(8); PG8_WAIT_L(0); PG8_BAR; PG8_MMA(1, 0, At, B0); PG8_MMA(1, 1, At, B1); PG8_BAR; PG8_SCHED;
        }
        if constexpr (ALIGN_EPI) { if (wr == 0) PG8_BAR; }
        E(acc, cur, ui, wr, wc, fr, fq, lds);
        if (!has_next) break;
#pragma unroll
        for (int a = 0; a < 2; ++a)
#pragma unroll
            for (int b = 0; b < 2; ++b)
#pragma unroll
                for (int m = 0; m < 4; ++m)
#pragma unroll
                    for (int n = 0; n < 2; ++n) acc[a][b][m][n] = (f32x4){0.f, 0.f, 0.f, 0.f};
        cur = nxt; cA = nA; cB = nB; ++ui;
        if constexpr (ALIGN_EPI) { if (wr == 1) PG8_BAR; }
    }
    PG8_WAIT_V(0);
    if constexpr (!ALIGN_EPI) { if (wr == 0) PG8_BAR; }
    PG8_BAR;
#undef PG8_SA
#undef PG8_SB
#undef PG8_STAGE
#undef PG8_LDA
#undef PG8_LDB
#undef PG8_MMA
#undef PG8_WAIT_V
#undef PG8_WAIT_L
#undef PG8_BAR
#undef PG8_SCHED
}
}

#define XB_TMO      128
#define XB_XCNT(j)  (256  + 64 * (j))
#define XB_XSUB(j)  (1280 + 64 * (j))
#define XB_XGEN(j)  (2304 + 64 * (j))
#define XB_TOP      3328
#define XB_TOPGEN   3392
#define XCD_BAR_WORDS 3456
#define XB_SPIN_CAP (1u << 18)
DI unsigned xb_ld(unsigned* p)              { return __hip_atomic_load(p, __ATOMIC_RELAXED, __HIP_MEMORY_SCOPE_AGENT); }
DI unsigned xb_add(unsigned* p, unsigned v) { return __hip_atomic_fetch_add(p, v, __ATOMIC_RELAXED, __HIP_MEMORY_SCOPE_AGENT); }
DI unsigned xb_xcc_id() { return (unsigned)__builtin_amdgcn_s_getreg((3 << 11) | 20) & 0xFu; }
#define XB_SPIN(cond, bar) do { unsigned _sp = 0; while (cond) { __builtin_amdgcn_s_sleep(1); \
    if ((++_sp & 255u) == 0u) { if (xb_ld(&(bar)[XB_TMO])) break; if (_sp > XB_SPIN_CAP) { atomicAdd(&(bar)[XB_TMO], 1u); break; } } } } while (0)
struct XcdBarrier { unsigned* bar; unsigned x; volatile LAS unsigned* st; };
DI XcdBarrier xcd_barrier_post(unsigned* bar, volatile LAS unsigned* st) {
    XcdBarrier b; b.bar = bar; b.x = xb_xcc_id(); b.st = st;
    if (threadIdx.x == 0) (void)xb_add(&bar[XB_XCNT(b.x)], 1u);
    return b;
}
DI void xcd_barrier_complete(unsigned* bar, unsigned x, unsigned& nloc, unsigned& nx) {
    const unsigned G = gridDim.x * gridDim.y * gridDim.z;
    unsigned sum, cnt, mine, sp = 0u;
    for (;;) {
        sum = 0u; cnt = 0u; mine = 0u;
#pragma unroll
        for (unsigned j = 0; j < 16; ++j) { const unsigned c = xb_ld(&bar[XB_XCNT(j)]); sum += c; cnt += (c > 0u) ? 1u : 0u; mine = (j == x) ? c : mine; }
        if (sum == G) break;
        __builtin_amdgcn_s_sleep(1);
        if ((++sp & 255u) == 0u) { if (xb_ld(&bar[XB_TMO])) break; if (sp > XB_SPIN_CAP) { atomicAdd(&bar[XB_TMO], 1u); break; } }
    }
    nloc = mine > 0u ? mine : 1u; nx = cnt > 0u ? cnt : 1u;
}
DI void xcd_barrier(const XcdBarrier& b) {
    asm volatile("s_waitcnt vmcnt(0)" ::: "memory");
    __syncthreads();
    if (threadIdx.x == 0) {
        unsigned* bar = b.bar;
        __builtin_amdgcn_s_waitcnt(0);
        unsigned nloc = b.st[0], nx = b.st[1];
        if (nloc == 0u) { xcd_barrier_complete(bar, b.x, nloc, nx); b.st[0] = nloc; b.st[1] = nx; }
        const unsigned old = xb_add(&bar[XB_XSUB(b.x)], 1u);
        const unsigned gen = old / nloc;
        if (old + 1u == (gen + 1u) * nloc) {
            __builtin_amdgcn_fence(__ATOMIC_RELEASE, "agent");
            asm volatile("s_waitcnt vmcnt(0)" ::: "memory");
            const unsigned og = xb_add(&bar[XB_TOP], 1u);
            const unsigned tg = og / nx;
            if (og + 1u == (tg + 1u) * nx) xb_add(&bar[XB_TOPGEN], 1u);
            else XB_SPIN(xb_ld(&bar[XB_TOPGEN]) == tg, bar);
            __builtin_amdgcn_fence(__ATOMIC_ACQUIRE, "agent");
            xb_add(&bar[XB_XGEN(b.x)], 1u);
            asm volatile("s_waitcnt vmcnt(0)" ::: "memory");
        } else {
            XB_SPIN(xb_ld(&bar[XB_XGEN(b.x)]) == gen, bar);
            __builtin_amdgcn_fence(__ATOMIC_ACQUIRE, "agent");
            asm volatile("s_waitcnt vmcnt(0)" ::: "memory");
        }
    }
    __syncthreads();
}

constexpr int RING_BYTES = 131072;
constexpr int RTAB_OFF = RING_BYTES;
constexpr int MISC_OFF = RING_BYTES + 2048;
constexpr int LDS_BYTES = 147456;

struct Args {
    const float* in[25]; float* out; unsigned char* ws; int pad0, pad1;
};

struct Frame {
    LAS unsigned char* lds; int tid, lane, wave, vcu, G;
    const float* const* dummy;
};

DI void p0_transpose_item(const float* W, int ldw, int k0s, int n0s, const float* gain, bf16* WT, int pitch, int n0d, int k0d, bool perm16, LAS float* scr, int lane) {
#pragma unroll 8
    for (int i = 0; i < 32; ++i) { const int kk = 2 * i + (lane >> 5); float v = W[(size_t)(k0s + kk) * ldw + n0s + (lane & 31)]; if (gain) v *= gain[k0s + kk]; scr[kk * 33 + (lane & 31)] = v; }
    LDS_WAIT(); asm volatile("" ::: "memory");
    const int c = lane & 7;
#pragma unroll
    for (int j = 0; j < 4; ++j) { const int n = (lane >> 3) + 8 * j;
        float e[8];
#pragma unroll
        for (int q = 0; q < 8; ++q) { const int kk = perm16 ? (16 * (c >> 1) + 8 * (q >> 2) + 4 * (c & 1) + (q & 3)) : (8 * c + q); e[q] = scr[kk * 33 + n]; }
        u32x4 o; o.x = cvtpk(e[0], e[1]); o.y = cvtpk(e[2], e[3]); o.z = cvtpk(e[4], e[5]); o.w = cvtpk(e[6], e[7]);
        *(GAS u32x4*)(WT + (size_t)(n0d + n) * pitch + k0d + 8 * c) = o; }
    LDS_WAIT(); asm volatile("" ::: "memory");
}
DI int win_src_col(int nd) {
    if (nd < 1024) { const int pn = nd >> 8, bj = (nd >> 7) & 1, x = nd & 127; return bj * 512 + 128 * pn + x; }
    if (nd < 2048) { const int rel = nd - 1024, kq = rel >> 9, rr = rel & 511, tp = rr >> 8, bj = (rr >> 7) & 1, wc = (rr >> 5) & 3, y = rr & 31; return 1024 + 512 * kq + 64 * (4 * tp + wc) + 32 * bj + y; }
    return nd;
}
DI void p0_prep(const Args& a, LAS unsigned char* lds, int vcu, int G, int wave, int lane) {
    asm volatile("" : "+v"(lane));
    LAS float* scr = (LAS float*)(lds + wave * 16384);
    unsigned char* ws = a.ws;
    const int gw = vcu * 8 + wave, NGW = G * 8;
    bf16* Win_t = (bf16*)(ws + WS_WIN); bf16* Wout_t = (bf16*)(ws + WS_WOUT); bf16* W1_t = (bf16*)(ws + WS_W1); bf16* W2_t = (bf16*)(ws + WS_W2); bf16* Wgp_t = (bf16*)(ws + WS_WGP);
    constexpr int I_IN = 16 * 80, I_OUT = 16 * 32, I_1 = 16 * 128, I_2 = 64 * 32, I_G = 16 * 32, I_P = 4 * 32, I_V = 8 * 8 * 16;
    constexpr int NIT = I_IN + I_OUT + I_1 + I_2 + I_G + I_P + I_V;
    for (int it = gw; it < NIT; it += NGW) {
        int r = it;
        if (r < I_IN) { const int kb = r / 80, nb = r % 80; p0_transpose_item(a.in[8], DIN, 64 * kb, win_src_col(32 * nb), a.in[7], Win_t, 1024, 32 * nb, 64 * kb, false, scr, lane); continue; } r -= I_IN;
        if (r < I_OUT) { const int kb = r / 32, nb = r % 32; const int k0 = 64 * kb; const float* gain = (k0 < 512) ? a.in[16] : (a.in[17] - 512);
            p0_transpose_item(a.in[18], DM, k0, 32 * nb, gain, Wout_t, 1024, 32 * nb, (k0 + 512) & 1023, false, scr, lane); continue; } r -= I_OUT;
        if (r < I_1) { const int kb = r / 128, nb = r % 128; p0_transpose_item(a.in[20], DFF, 64 * kb, 32 * nb, a.in[19], W1_t, 1024, 32 * nb, 64 * kb, false, scr, lane); continue; } r -= I_1;
        if (r < I_2) { const int kb = r / 32, nb = r % 32; p0_transpose_item(a.in[21], DM, 64 * kb, 32 * nb, nullptr, W2_t, 4096, 32 * nb, 64 * kb, false, scr, lane); continue; } r -= I_2;
        if (r < I_G) { const int kb = r / 32, nb = r % 32; p0_transpose_item(a.in[23], DM, 64 * kb, 32 * nb, a.in[22], Wgp_t, 1280, 32 * nb, 64 * kb, false, scr, lane); continue; } r -= I_G;
        if (r < I_P) { const int kb = r / 32, nb = r % 32; p0_transpose_item(a.in[24], DM, 64 * kb, 32 * nb, nullptr, Wgp_t, 1280, 32 * nb, 1024 + 64 * kb, false, scr, lane); continue; } r -= I_P;
        { const int b = r / 128, rr = r % 128, kb = rr / 16, nb = rr % 16;
          p0_transpose_item(a.in[5] + (size_t)b * KEEP * DATT, DATT, 64 * kb, 32 * nb, nullptr, (bf16*)(ws + WS_VCT) + (size_t)b * DATT * KEEP, KEEP, 32 * nb, 64 * kb, true, scr, lane); }
    }
    bf16* xb = (bf16*)(ws + WS_XB); float* rmix = (float*)(ws + WS_RMIX); bf16* acat = (bf16*)(ws + WS_ACAT); bf16* kc = (bf16*)(ws + WS_KC);
    for (int m = gw; m < R; m += NGW) {
        const float* xrow = (m < RP) ? a.in[0] + (size_t)m * DM : a.in[1] + (size_t)(m - RP) * DM;
        const GAS f32x4* xr = (const GAS f32x4*)xrow + lane;
        f32x4 v[4]; float s = 0.f;
#pragma unroll
        for (int j = 0; j < 4; ++j) { v[j] = xr[64 * j]; s += (v[j].x * v[j].x + v[j].y * v[j].y) + (v[j].z * v[j].z + v[j].w * v[j].w); }
        s = wave_sum(s);
        if (lane == 0) rmix[m] = 1.0f / sqrtf(s * (1.f / DM) + EPS);
        GAS u32x2* o8 = (GAS u32x2*)(xb + (size_t)m * DM) + lane;
#pragma unroll
        for (int j = 0; j < 4; ++j) { u32x2 w; w.x = cvtpk(v[j].x, v[j].y); w.y = cvtpk(v[j].z, v[j].w); o8[64 * j] = w; }
        const float* prow = (m < RP) ? a.in[2] + (size_t)m * DPLE : a.in[3] + (size_t)(m - RP) * DPLE;
        const f32x4 pv = ((const GAS f32x4*)prow)[lane];
        u32x2 w; w.x = cvtpk(pv.x, pv.y); w.y = cvtpk(pv.z, pv.w);
        *((GAS u32x2*)(acat + (size_t)m * 1280 + 1024) + lane) = w;
    }
    for (int m = gw; m < NB * KEEP; m += NGW) {
        const GAS f32x4* kr = (const GAS f32x4*)(a.in[4] + (size_t)m * DATT) + lane;
        const f32x4 v0 = kr[0], v1 = kr[64];
        GAS u32x2* o8 = (GAS u32x2*)(kc + (size_t)m * DATT) + lane;
        u32x2 w0, w1; w0.x = cvtpk(v0.x, v0.y); w0.y = cvtpk(v0.z, v0.w); w1.x = cvtpk(v1.x, v1.y); w1.y = cvtpk(v1.z, v1.w);
        o8[0] = w0; o8[64] = w1;
    }
}

struct SchedP1 {
    const char* xb; const char* win; int G, vcu;
    DI bool next(int i, pg8::Unit& u) const {
        const int L = i * G + vcu; if (L >= 660) return false;
        const int T = L / 10, j = L % 10;
        if (j < 8) { u.A = xb + (size_t)T * 256 * 2048; u.B = win + (size_t)j * 256 * 2048; u.kind = (j < 4) ? 0 : (j < 6 ? 1 : 2); u.pm = T; u.pn = j; }
        else { u.A = win + (size_t)(8 + (j - 8)) * 256 * 2048; u.B = xb + (size_t)T * 256 * 2048; u.kind = 3; u.pm = j - 8; u.pn = T; }
        u.nt = 16; return true;
    }
};
struct EpiP1 {
    static constexpr bool HAS_MID = false; static constexpr int MID_T = -1;
    const float* rmix; bf16* ub; bf16* qb; bf16* kb; bf16* vtp; bf16* vts; float* out; const float* gq; const float* gk;
    DI void a_ready(const pg8::Unit&, int, LAS unsigned char*) const {}
    DI void mid(f32x4 (&)[2][2][4][2], const pg8::Unit&, int, int, int, int, int, LAS unsigned char*) const {}
    DI void operator()(const f32x4 (&acc)[2][2][4][2], const pg8::Unit& u, int, int wr, int wc, int fr, int fq, LAS unsigned char*) const {
        if (u.kind == 0) {
            const int ch0 = 128 * u.pn + 32 * wc + 8 * fq;
#pragma unroll
            for (int ai = 0; ai < 2; ++ai)
#pragma unroll
                for (int m = 0; m < 4; ++m) {
                    const int row = u.pm * 256 + ai * 128 + wr * 64 + m * 16 + fr; const float r = rmix[row];
                    f32x4 v[2];
#pragma unroll
                    for (int n = 0; n < 2; ++n) { const f32x4 a_ = acc[ai][0][m][n] * r, g_ = acc[ai][1][m][n] * r;
                        v[n] = (f32x4){a_[0] * sigmoidf_(g_[0]), a_[1] * sigmoidf_(g_[1]), a_[2] * sigmoidf_(g_[2]), a_[3] * sigmoidf_(g_[3])}; }
                    u32x4 w; w.x = cvtpk(v[0][0], v[0][1]); w.y = cvtpk(v[0][2], v[0][3]); w.z = cvtpk(v[1][0], v[1][1]); w.w = cvtpk(v[1][2], v[1][3]);
                    *(u32x4*)(ub + (size_t)row * DCONV + ch0) = w;
                    int orow = -1; size_t obase = 0;
                    if (row < RP) { const int b = row >> 11, t = row & 2047; if (t >= SEQ - CST) { orow = b * CST + (t - (SEQ - CST)); obase = O_CP; } }
                    else { const int rs = row - RP, b = rs >> 6, t = rs & 63; if (t >= DSEQ - CST) { orow = b * CST + (t - (DSEQ - CST)); obase = O_CS; } }
                    if (orow >= 0) { float* o = out + obase + (size_t)orow * DCONV + ch0; *(f32x4*)o = v[0]; *(f32x4*)(o + 4) = v[1]; }
                }
        } else if (u.kind == 3) {
            const int T = u.pn;
            f32x4 rv[2][2];
#pragma unroll
            for (int bj = 0; bj < 2; ++bj)
#pragma unroll
                for (int n = 0; n < 2; ++n) rv[bj][n] = *(const f32x4*)(rmix + T * 256 + bj * 128 + wc * 32 + 8 * fq + 4 * n);
#pragma unroll
            for (int ai = 0; ai < 2; ++ai)
#pragma unroll
                for (int m = 0; m < 4; ++m) {
                    const int vcol = u.pm * 256 + ai * 128 + wr * 64 + m * 16 + fr;
#pragma unroll
                    for (int bj = 0; bj < 2; ++bj)
#pragma unroll
                        for (int n = 0; n < 2; ++n) {
                            const f32x4 v = acc[ai][bj][m][n] * rv[bj][n];
                            u32x2 w; w.x = cvtpk(v[0], v[1]); w.y = cvtpk(v[2], v[3]);
                            const int slot = 16 * (fq >> 1) + 4 * (2 * n + (fq & 1));
                            if (T < 64) { const int b = T >> 3, t0 = (T & 7) * 256 + bj * 128 + wc * 32;
                                *(u32x2*)(vtp + ((size_t)(b * DATT + vcol) * SEQ + t0 + slot)) = w;
                                if ((T & 7) >= 6) { const int t = t0 + 8 * fq + 4 * n - (SEQ - KEEP); float* o = out + O_VP + ((size_t)(b * KEEP + t) * DATT + vcol);
                                    o[0] = v[0]; o[DATT] = v[1]; o[2 * DATT] = v[2]; o[3 * DATT] = v[3]; } }
                            else { const int tk0 = (T - 64) * 256 + bj * 128 + wc * 32, b = tk0 >> 6, t0 = tk0 & 63;
                                *(u32x2*)(vts + ((size_t)(b * DATT + vcol) * DSEQ + t0 + slot)) = w;
                                float* o = out + O_VS + ((size_t)(tk0 + 8 * fq + 4 * n) * DATT + vcol);
                                o[0] = v[0]; o[DATT] = v[1]; o[2 * DATT] = v[2]; o[3 * DATT] = v[3]; }
                        }
                }
        } else {
            const bool isk = (u.kind == 2);
            const float* g = isk ? gk : gq; bf16* dst = isk ? kb : qb;
            const int hd = 4 * (u.pn & 1) + wc;
            f32x4 gv[2][2];
#pragma unroll
            for (int bj = 0; bj < 2; ++bj)
#pragma unroll
                for (int n = 0; n < 2; ++n) gv[bj][n] = *(const f32x4*)(g + 32 * bj + 8 * fq + 4 * n);
#pragma unroll
            for (int ai = 0; ai < 2; ++ai)
#pragma unroll
                for (int m = 0; m < 4; ++m) {
                    const int row = u.pm * 256 + ai * 128 + wr * 64 + m * 16 + fr; const float r = rmix[row];
                    float ss = 0.f;
#pragma unroll
                    for (int bj = 0; bj < 2; ++bj)
#pragma unroll
                        for (int n = 0; n < 2; ++n) { const f32x4 x = acc[ai][bj][m][n]; ss += (x[0] * x[0] + x[1] * x[1]) + (x[2] * x[2] + x[3] * x[3]); }
                    ss += __shfl_xor(ss, 16); ss += __shfl_xor(ss, 32);
                    float rs = r / sqrtf(ss * r * r * (1.f / HD) + EPS);
                    if (!isk) rs *= C2;
                    int orow = -1; size_t obase = 0;
                    if (isk) { if (row < RP) { const int b = row >> 11, t = row & 2047; if (t >= SEQ - KEEP) { orow = b * KEEP + (t - (SEQ - KEEP)); obase = O_KP; } } else { orow = row - RP; obase = O_KS; } }
#pragma unroll
                    for (int bj = 0; bj < 2; ++bj) {
                        const f32x4 v0 = acc[ai][bj][m][0] * rs * gv[bj][0], v1 = acc[ai][bj][m][1] * rs * gv[bj][1];
                        u32x4 w; w.x = cvtpk(v0[0], v0[1]); w.y = cvtpk(v0[2], v0[3]); w.z = cvtpk(v1[0], v1[1]); w.w = cvtpk(v1[2], v1[3]);
                        const int col = hd * HD + 32 * bj + 8 * fq;
                        *(u32x4*)(dst + (size_t)row * DATT + col) = w;
                        if (orow >= 0) { float* o = out + obase + (size_t)orow * DATT + col; *(f32x4*)o = v0; *(f32x4*)(o + 4) = v1; }
                    }
                }
        }
    }
};


constexpr int AT_KS = 0, AT_KPITCH = 528, AT_VS = 64 * AT_KPITCH, AT_VPITCH = 144, AT_BIAS = AT_VS + 256 * AT_VPITCH, AT_BIASP = 260, AT_OST = AT_BIAS + 4 * AT_BIASP * 4 + 64, AT_OPITCH = 144;
static_assert(AT_OST % 16 == 0 && AT_OST + 8 * 32 * AT_OPITCH <= RING_BYTES, "attention LDS map");
DI int crow(int reg, int hi) { return (reg & 3) + 8 * (reg >> 2) + 4 * hi; }
DI bf16x8 pack8(const f32x16& x, int s) {
    u32x4 p; p.x = cvtpk(x[8 * s], x[8 * s + 1]); p.y = cvtpk(x[8 * s + 2], x[8 * s + 3]); p.z = cvtpk(x[8 * s + 4], x[8 * s + 5]); p.w = cvtpk(x[8 * s + 6], x[8 * s + 7]);
    return __builtin_bit_cast(bf16x8, p);
}
DI void attn_unit(const Args& a, LAS unsigned char* lds, int cidx, int hg, int tid, int wave, int lane) {
    asm volatile("" : "+v"(tid), "+v"(lane));
    unsigned char* ws = a.ws;
    const bf16* Qb = (const bf16*)(ws + WS_QB); const bf16* Kb = (const bf16*)(ws + WS_KB); const bf16* VTp = (const bf16*)(ws + WS_VTP); const bf16* VTs = (const bf16*)(ws + WS_VTS);
    const bf16* Kc = (const bf16*)(ws + WS_KC); const bf16* VcT = (const bf16*)(ws + WS_VCT); bf16* mrg = (bf16*)(ws + WS_MRG); float* ssqa = (float*)(ws + WS_SSQA);
    const bool smp = cidx >= 256; const int b = smp ? cidx - 256 : cidx >> 5, n = smp ? 8 : (cidx & 31);
    const int row0 = smp ? RP + 64 * b : b * SEQ + 64 * n;
    const int j0 = smp ? 0 : (n >= 8 ? 0 : 8 - n);
    const int hl = wave >> 1, qh = wave & 1, c = lane & 31, hi = lane >> 5, head = 4 * hg + hl;
    LAS float* biasl = (LAS float*)(lds + AT_BIAS);
    for (int i = tid; i < 4 * 257; i += 512) { const int h4 = i / 257, ii = i % 257; biasl[h4 * AT_BIASP + ii] = a.in[15][(4 * hg + h4) * 257 + ii] * LOG2E; }
    bf16x8 qf[4];
    { const bf16* qp = Qb + (size_t)(row0 + 32 * qh + c) * DATT + head * HD + 8 * hi;
#pragma unroll
      for (int s = 0; s < 4; ++s) qf[s] = *(const bf16x8*)(qp + 16 * s); }
    f32x16 ot0 = {}, ot1 = {};
    float m_run = -1e30f, l_run = 0.f;
    u32x4 kreg[4], vreg[4];
    auto issue = [&](int j) {
        const bf16* kp; size_t kpitch; const bf16* vp; size_t vpitch;
        if (!smp) { const int kc = n - 8 + j; kp = Kb + (size_t)(b * SEQ + 64 * kc) * DATT + hg * 256; kpitch = DATT; vp = VTp + (size_t)(b * DATT + hg * 256) * SEQ + 64 * kc; vpitch = SEQ; }
        else if (j < 8) { kp = Kc + (size_t)(b * KEEP + 64 * j) * DATT + hg * 256; kpitch = DATT; vp = VcT + (size_t)(b * DATT + hg * 256) * KEEP + 64 * j; vpitch = KEEP; }
        else { kp = Kb + (size_t)(RP + 64 * b) * DATT + hg * 256; kpitch = DATT; vp = VTs + (size_t)(b * DATT + hg * 256) * DSEQ; vpitch = DSEQ; }
#pragma unroll
        for (int i = 0; i < 4; ++i) { const int id = tid + 512 * i;
            kreg[i] = *(const u32x4*)(kp + (size_t)(id >> 5) * kpitch + (id & 31) * 8);
            vreg[i] = *(const u32x4*)(vp + (size_t)(id >> 3) * vpitch + (id & 7) * 8); }
    };
    issue(j0);
    for (int j = j0; j < 9; ++j) {
#pragma unroll
        for (int i = 0; i < 4; ++i) { const int id = tid + 512 * i;
            *(LAS u32x4*)(lds + AT_KS + (id >> 5) * AT_KPITCH + (id & 31) * 16) = kreg[i];
            *(LAS u32x4*)(lds + AT_VS + (id >> 3) * AT_VPITCH + (id & 7) * 16) = vreg[i]; }
        __syncthreads();
        if (j < 8) issue(j + 1);
        f32x16 st0 = {}, st1 = {};
        { const LAS unsigned char* kb0 = lds + AT_KS + c * AT_KPITCH + hl * 128 + hi * 16;
#pragma unroll
          for (int s = 0; s < 4; ++s) {
              const bf16x8 k0 = *(const LAS bf16x8*)(kb0 + s * 32);
              const bf16x8 k1 = *(const LAS bf16x8*)(kb0 + 32 * AT_KPITCH + s * 32);
              st0 = __builtin_amdgcn_mfma_f32_32x32x16_bf16(k0, qf[s], st0, 0, 0, 0);
              st1 = __builtin_amdgcn_mfma_f32_32x32x16_bf16(k1, qf[s], st1, 0, 0, 0); } }
        if (j <= 5) { const float b0 = biasl[hl * AT_BIASP];
#pragma unroll
            for (int r = 0; r < 16; ++r) { st0[r] += b0; st1[r] += b0; } }
        else { const int base = 64 * (j - 6) - (32 * qh + c) + 4 * hi; const LAS float* bl = biasl + hl * AT_BIASP;
#pragma unroll
            for (int r = 0; r < 16; ++r) { const int i0 = base + (r & 3) + 8 * (r >> 2); const int i1 = i0 + 32;
                st0[r] += bl[i0 > 0 ? i0 : 0]; st1[r] += bl[i1 > 0 ? i1 : 0]; } }
        float mx = st0[0];
#pragma unroll
        for (int r = 1; r < 16; ++r) mx = fmaxf(mx, st0[r]);
#pragma unroll
        for (int r = 0; r < 16; ++r) mx = fmaxf(mx, st1[r]);
        mx = fmaxf(mx, __shfl_xor(mx, 32));
        const float mnew = fmaxf(m_run, mx); const float alpha = __builtin_amdgcn_exp2f(m_run - mnew); m_run = mnew;
        float ls = 0.f;
#pragma unroll
        for (int r = 0; r < 16; ++r) { st0[r] = __builtin_amdgcn_exp2f(st0[r] - mnew); st1[r] = __builtin_amdgcn_exp2f(st1[r] - mnew); ls += st0[r] + st1[r]; }
        l_run = l_run * alpha + ls;
#pragma unroll
        for (int r = 0; r < 16; ++r) { ot0[r] *= alpha; ot1[r] *= alpha; }
        { const bf16x8 p0 = pack8(st0, 0), p1 = pack8(st0, 1), p2 = pack8(st1, 0), p3 = pack8(st1, 1);
          const LAS unsigned char* vb0 = lds + AT_VS + (hl * 64 + c) * AT_VPITCH + hi * 16;
#define AT_PV(P, KS) do { const bf16x8 v0 = *(const LAS bf16x8*)(vb0 + (KS) * 32); const bf16x8 v1 = *(const LAS bf16x8*)(vb0 + 32 * AT_VPITCH + (KS) * 32); \
              ot0 = __builtin_amdgcn_mfma_f32_32x32x16_bf16(v0, P, ot0, 0, 0, 0); ot1 = __builtin_amdgcn_mfma_f32_32x32x16_bf16(v1, P, ot1, 0, 0, 0); } while (0)
          AT_PV(p0, 0); AT_PV(p1, 1); AT_PV(p2, 2); AT_PV(p3, 3);
#undef AT_PV
        }
        __syncthreads();
    }
    const float lt = l_run + __shfl_xor(l_run, 32); const float inv = 1.0f / lt;
    float sq = 0.f;
#pragma unroll
    for (int r = 0; r < 16; ++r) { ot0[r] *= inv; ot1[r] *= inv; sq += ot0[r] * ot0[r] + ot1[r] * ot1[r]; }
    sq += __shfl_xor(sq, 32);
    if (hi == 0) ssqa[(size_t)(row0 + 32 * qh + c) * NH + head] = sq;
    LAS unsigned char* ost = lds + AT_OST + wave * (32 * AT_OPITCH);
#pragma unroll
    for (int r = 0; r < 16; r += 2) { const int d = crow(r, hi);
        *(LAS unsigned*)(ost + c * AT_OPITCH + d * 2) = cvtpk(ot0[r], ot0[r + 1]);
        *(LAS unsigned*)(ost + c * AT_OPITCH + (32 + d) * 2) = cvtpk(ot1[r], ot1[r + 1]); }
    LDS_WAIT();
#pragma unroll
    for (int i = 0; i < 4; ++i) { const int row = i * 8 + (lane >> 3), ch = lane & 7;
        const u32x4 v = *(const LAS u32x4*)(ost + row * AT_OPITCH + ch * 16);
        *(u32x4*)(mrg + (size_t)(row0 + 32 * qh + row) * DM + head * HD + ch * 8) = v; }
    LDS_WAIT();
}

DI void conv_item(const Args& a, LAS unsigned char* lds, int idx, int tid, int wave, int lane) {
    asm volatile("" : "+v"(tid), "+v"(lane));
    unsigned char* ws = a.ws;
    const bf16* ub = (const bf16*)(ws + WS_UB); bf16* mrg = (bf16*)(ws + WS_MRG);
    const bool smp = idx >= 512; const int b = smp ? (idx - 512) >> 1 : idx >> 6, t0 = smp ? 32 * ((idx - 512) & 1) : 32 * (idx & 63);
    const int rowb = smp ? RP + 64 * b : b * SEQ;
    LAS float* Y = (LAS float*)lds;
    {
        const int ch = tid;
        float win[62];
#pragma unroll
        for (int i = 0; i < 62; ++i) { const int tt = t0 - CST + i;
            float v;
            if (tt >= 0) v = bf2f(ub[(size_t)(rowb + tt) * DCONV + ch]);
            else v = smp ? a.in[6][(size_t)(b * CST + (tt + CST)) * DCONV + ch] : 0.f;
            win[i] = v; }
        float w[31];
#pragma unroll
        for (int j = 0; j < 31; ++j) w[j] = a.in[9][j * DCONV + ch];
        const float bd = a.in[10][ch];
#pragma unroll
        for (int o = 0; o < 32; ++o) { float acc = bd;
#pragma unroll
            for (int j = 0; j < 31; ++j) acc = fmaf(w[j], win[o + j], acc);
            Y[o * 512 + ch] = acc; }
    }
    __syncthreads();
    {
        const f32x4 g0 = *(const f32x4*)(a.in[11] + 8 * lane), g1 = *(const f32x4*)(a.in[11] + 8 * lane + 4);
        const f32x4 be0 = *(const f32x4*)(a.in[12] + 8 * lane), be1 = *(const f32x4*)(a.in[12] + 8 * lane + 4);
#pragma unroll
        for (int q = 0; q < 4; ++q) { const int o = 4 * wave + q;
            f32x4 y0 = *(const LAS f32x4*)(Y + o * 512 + 8 * lane), y1 = *(const LAS f32x4*)(Y + o * 512 + 8 * lane + 4);
            const float mean = wave_sum((y0[0] + y0[1]) + (y0[2] + y0[3]) + (y1[0] + y1[1]) + (y1[2] + y1[3])) * (1.f / DCONV);
            y0 = y0 - mean; y1 = y1 - mean;
            const float var = wave_sum((y0[0] * y0[0] + y0[1] * y0[1]) + (y0[2] * y0[2] + y0[3] * y0[3]) + (y1[0] * y1[0] + y1[1] * y1[1]) + (y1[2] * y1[2] + y1[3] * y1[3])) * (1.f / DCONV);
            const float rstd = 1.0f / sqrtf(var + EPS);
            y0 = y0 * rstd * g0 + be0; y1 = y1 * rstd * g1 + be1;
            float s[8]; float ss = 0.f;
#pragma unroll
            for (int e = 0; e < 4; ++e) { s[e] = y0[e] * sigmoidf_(y0[e]); s[4 + e] = y1[e] * sigmoidf_(y1[e]); }
#pragma unroll
            for (int e = 0; e < 8; ++e) ss += s[e] * s[e];
            const float rr = 1.0f / sqrtf(wave_sum(ss) * (1.f / DCONV) + EPS);
            u32x4 wv; wv.x = cvtpk(s[0] * rr, s[1] * rr); wv.y = cvtpk(s[2] * rr, s[3] * rr); wv.z = cvtpk(s[4] * rr, s[5] * rr); wv.w = cvtpk(s[6] * rr, s[7] * rr);
            *(u32x4*)(mrg + (size_t)(rowb + t0 + o) * DM + DATT + 8 * lane) = wv; }
    }
    __syncthreads();
}

DI void rtab_fill16(const float* ssqp, float scale_n, int pm, int ui, bool square, LAS unsigned char* lds) {
    int tid = threadIdx.x; asm volatile("" : "+v"(tid));
    if (tid < 256) { const f32x4* p = (const f32x4*)(ssqp + (size_t)(pm * 256 + tid) * 16);
        const f32x4 s0 = p[0], s1 = p[1], s2 = p[2], s3 = p[3];
        const float t = ((s0[0] + s0[1]) + (s0[2] + s0[3])) + ((s1[0] + s1[1]) + (s1[2] + s1[3])) + ((s2[0] + s2[1]) + (s2[2] + s2[3])) + ((s3[0] + s3[1]) + (s3[2] + s3[3]));
        const float r = 1.0f / sqrtf(t * scale_n + EPS);
        ((LAS float*)(lds + RTAB_OFF))[(ui & 1) * 256 + tid] = square ? r * r : r; }
}
struct SchedP3 { const char* A; const char* B; int G, vcu;
    DI bool next(int i, pg8::Unit& u) const { const int L = i * G + vcu; if (L >= 264) return false; u.pm = L >> 2; u.pn = L & 3; u.A = A + (size_t)u.pm * 256 * 2048; u.B = B + (size_t)u.pn * 256 * 2048; u.nt = 16; u.kind = 0; return true; } };
struct SchedP4 { const char* A; const char* B; int G, vcu;
    DI bool next(int i, pg8::Unit& u) const { const int L = i * G + vcu; if (L >= 1056) return false; u.pm = L >> 4; u.pn = L & 15; u.A = A + (size_t)u.pm * 256 * 2048; u.B = B + (size_t)u.pn * 256 * 2048; u.nt = 16; u.kind = 0; return true; } };
struct SchedP5 { const char* A; const char* B; int G, vcu;
    DI bool next(int i, pg8::Unit& u) const { const int L = i * G + vcu; if (L >= 264) return false; u.pm = L >> 2; u.pn = L & 3; u.A = A + (size_t)u.pm * 256 * 8192; u.B = B + (size_t)u.pn * 256 * 8192; u.nt = 64; u.kind = 0; return true; } };
struct SchedP6 { const char* A; const char* B; int G, vcu;
    DI bool next(int i, pg8::Unit& u) const { const int L = (i >> 1) * G + vcu; if (L >= 264) return false; u.pm = L >> 2; u.pn = L & 3; const int sub = i & 1;
        u.A = A + (size_t)u.pm * 256 * 2560 + (sub ? 0 : 2048); u.B = B + (size_t)u.pn * 256 * 2560 + (sub ? 0 : 2048); u.nt = sub ? 16 : 4; u.kind = sub; return true; } };

template <bool IS3> struct EpiRes {
    static constexpr bool HAS_MID = IS3; static constexpr int MID_T = 8;
    const float* xp; const float* xs; float* out; bf16* xbo; int ldb; float* ssqp; const float* ssqa;
    DI void a_ready(const pg8::Unit& u, int ui, LAS unsigned char* lds) const {
        if constexpr (IS3) { int tid = threadIdx.x; asm volatile("" : "+v"(tid));
            if (tid < 256) { const f32x4* p = (const f32x4*)(ssqa + (size_t)(u.pm * 256 + tid) * NH); const f32x4 s0 = p[0], s1 = p[1];
                const float t = ((s0[0] + s0[1]) + (s0[2] + s0[3])) + ((s1[0] + s1[1]) + (s1[2] + s1[3]));
                ((LAS float*)(lds + RTAB_OFF))[(ui & 1) * 256 + tid] = 1.0f / sqrtf(t * (1.f / DATT) + EPS); } }
    }
    DI void mid(f32x4 (&acc)[2][2][4][2], const pg8::Unit&, int ui, int wr, int, int fr, int, LAS unsigned char* lds) const {
        const LAS float* rt = (const LAS float*)(lds + RTAB_OFF) + (ui & 1) * 256;
#pragma unroll
        for (int ai = 0; ai < 2; ++ai)
#pragma unroll
            for (int m = 0; m < 4; ++m) { const float s = rt[ai * 128 + wr * 64 + m * 16 + fr];
#pragma unroll
                for (int bj = 0; bj < 2; ++bj)
#pragma unroll
                    for (int n = 0; n < 2; ++n) acc[ai][bj][m][n] *= s; }
    }
    DI void operator()(const f32x4 (&acc)[2][2][4][2], const pg8::Unit& u, int, int wr, int wc, int fr, int fq, LAS unsigned char*) const {
#pragma unroll
        for (int ai = 0; ai < 2; ++ai)
#pragma unroll
            for (int m = 0; m < 4; ++m) {
                const int row = u.pm * 256 + ai * 128 + wr * 64 + m * 16 + fr;
                const float* src = IS3 ? ((row < RP) ? xp + (size_t)row * DM : xs + (size_t)(row - RP) * DM) : out + (size_t)row * DM;
                float ss = 0.f;
#pragma unroll
                for (int bj = 0; bj < 2; ++bj) { const int col = u.pn * 256 + bj * 128 + wc * 32 + 8 * fq;
                    const f32x4 v0 = *(const f32x4*)(src + col) + acc[ai][bj][m][0], v1 = *(const f32x4*)(src + col + 4) + acc[ai][bj][m][1];
                    *(f32x4*)(out + (size_t)row * DM + col) = v0; *(f32x4*)(out + (size_t)row * DM + col + 4) = v1;
                    u32x4 w; w.x = cvtpk(v0[0], v0[1]); w.y = cvtpk(v0[2], v0[3]); w.z = cvtpk(v1[0], v1[1]); w.w = cvtpk(v1[2], v1[3]);
                    *(u32x4*)(xbo + (size_t)row * ldb + col) = w;
                    ss += (v0[0] * v0[0] + v0[1] * v0[1]) + (v0[2] * v0[2] + v0[3] * v0[3]) + (v1[0] * v1[0] + v1[1] * v1[1]) + (v1[2] * v1[2] + v1[3] * v1[3]); }
                ss += __shfl_xor(ss, 16); ss += __shfl_xor(ss, 32);
                if (fq == 0) ssqp[(size_t)row * 16 + u.pn * 4 + wc] = ss;
            }
    }
};
struct EpiP4 {
    static constexpr bool HAS_MID = false; static constexpr int MID_T = -1;
    const float* ssq1p; bf16* hb;
    DI void a_ready(const pg8::Unit& u, int ui, LAS unsigned char* lds) const { rtab_fill16(ssq1p, 1.f / DM, u.pm, ui, true, lds); }
    DI void mid(f32x4 (&)[2][2][4][2], const pg8::Unit&, int, int, int, int, int, LAS unsigned char*) const {}
    DI void operator()(const f32x4 (&acc)[2][2][4][2], const pg8::Unit& u, int ui, int wr, int wc, int fr, int fq, LAS unsigned char* lds) const {
        const LAS float* rt = (const LAS float*)(lds + RTAB_OFF) + (ui & 1) * 256;
#pragma unroll
        for (int ai = 0; ai < 2; ++ai)
#pragma unroll
            for (int m = 0; m < 4; ++m) { const int rl = ai * 128 + wr * 64 + m * 16 + fr; const float s2 = rt[rl];
                bf16* rowp = hb + (size_t)(u.pm * 256 + rl) * DFF + u.pn * 256 + wc * 32 + 8 * fq;
#pragma unroll
                for (int bj = 0; bj < 2; ++bj) { f32x4 v0 = acc[ai][bj][m][0], v1 = acc[ai][bj][m][1];
#pragma unroll
                    for (int e = 0; e < 4; ++e) { const float p0 = fmaxf(v0[e], 0.f), p1 = fmaxf(v1[e], 0.f); v0[e] = p0 * p0 * s2; v1[e] = p1 * p1 * s2; }
                    u32x4 w; w.x = cvtpk(v0[0], v0[1]); w.y = cvtpk(v0[2], v0[3]); w.z = cvtpk(v1[0], v1[1]); w.w = cvtpk(v1[2], v1[3]);
                    *(u32x4*)(rowp + bj * 128) = w; } }
    }
};
struct EpiP6 {
    static constexpr bool HAS_MID = false; static constexpr int MID_T = -1;
    const float* ssq2p; bf16* pleb; float* out;
    DI void a_ready(const pg8::Unit& u, int ui, LAS unsigned char* lds) const { if (u.kind == 1) rtab_fill16(ssq2p, 1.f / DM, u.pm, ui, false, lds); }
    DI void mid(f32x4 (&)[2][2][4][2], const pg8::Unit&, int, int, int, int, int, LAS unsigned char*) const {}
    DI void operator()(const f32x4 (&acc)[2][2][4][2], const pg8::Unit& u, int ui, int wr, int wc, int fr, int fq, LAS unsigned char* lds) const {
        const LAS float* rt = (const LAS float*)(lds + RTAB_OFF) + (ui & 1) * 256;
#pragma unroll
        for (int ai = 0; ai < 2; ++ai)
#pragma unroll
            for (int m = 0; m < 4; ++m) { const int rl = ai * 128 + wr * 64 + m * 16 + fr; const size_t row = (size_t)(u.pm * 256 + rl);
#pragma unroll
                for (int bj = 0; bj < 2; ++bj) { const int col = u.pn * 256 + bj * 128 + wc * 32 + 8 * fq;
                    const f32x4 v0 = acc[ai][bj][m][0], v1 = acc[ai][bj][m][1];
                    if (u.kind == 0) { u32x4 w; w.x = cvtpk(v0[0], v0[1]); w.y = cvtpk(v0[2], v0[3]); w.z = cvtpk(v1[0], v1[1]); w.w = cvtpk(v1[2], v1[3]);
                        *(u32x4*)(pleb + row * DM + col) = w; }
                    else { const float s = rt[rl];
                        const u32x4 pw = *(const u32x4*)(pleb + row * DM + col);
                        const f32x4 x0 = *(const f32x4*)(out + row * DM + col), x1 = *(const f32x4*)(out + row * DM + col + 4);
                        f32x4 o0, o1;
                        o0[0] = x0[0] + __uint_as_float(pw.x << 16) * sigmoidf_(v0[0] * s); o0[1] = x0[1] + __uint_as_float(pw.x & 0xffff0000u) * sigmoidf_(v0[1] * s);
                        o0[2] = x0[2] + __uint_as_float(pw.y << 16) * sigmoidf_(v0[2] * s); o0[3] = x0[3] + __uint_as_float(pw.y & 0xffff0000u) * sigmoidf_(v0[3] * s);
                        o1[0] = x1[0] + __uint_as_float(pw.z << 16) * sigmoidf_(v1[0] * s); o1[1] = x1[1] + __uint_as_float(pw.z & 0xffff0000u) * sigmoidf_(v1[1] * s);
                        o1[2] = x1[2] + __uint_as_float(pw.w << 16) * sigmoidf_(v1[2] * s); o1[3] = x1[3] + __uint_as_float(pw.w & 0xffff0000u) * sigmoidf_(v1[3] * s);
                        *(f32x4*)(out + row * DM + col) = o0; *(f32x4*)(out + row * DM + col + 4) = o1; } } }
    }
};

__global__ void __launch_bounds__(512, 2) fwd_kernel(Args args) {
    extern __shared__ __attribute__((aligned(16))) unsigned char lds_raw[];
    LAS unsigned char* lds = (LAS unsigned char*)lds_raw;
    volatile LAS unsigned* MISC = (volatile LAS unsigned*)(lds + MISC_OFF);
    const int tid = threadIdx.x, lane = tid & 63, wave = __builtin_amdgcn_readfirstlane(tid >> 6);
    const int G = gridDim.x; const int bx = blockIdx.x; const int vcu = (G % 8 == 0) ? (bx % 8) * (G / 8) + bx / 8 : bx;
    unsigned char* ws = args.ws;
    gu32* ctl = (gu32*)(ws + WS_CTL);
    for (int u = tid; u < (LDS_BYTES - RING_BYTES) / 4; u += 512) ((LAS unsigned*)(lds + RING_BYTES))[u] = 0u;
    __syncthreads();
    XcdBarrier bar = xcd_barrier_post((unsigned*)(ctl + CW_BAR), MISC + 8);

    p0_prep(args, lds, vcu, G, wave, lane);
    xcd_barrier(bar);
    {
        SchedP1 S{(const char*)(ws + WS_XB), (const char*)(ws + WS_WIN), G, vcu};
        EpiP1 E{(const float*)(ws + WS_RMIX), (bf16*)(ws + WS_UB), (bf16*)(ws + WS_QB), (bf16*)(ws + WS_KB), (bf16*)(ws + WS_VTP), (bf16*)(ws + WS_VTS), args.out, args.in[13], args.in[14]};
        pg8::gemm_phase<EpiP1, SchedP1, true>(lds, 1024, S, E);
    }
    xcd_barrier(bar);
    for (int it = vcu; it < 1056; it += G) {
        if (it < 528) attn_unit(args, lds, it >> 1, it & 1, tid, wave, lane);
        else conv_item(args, lds, it - 528, tid, wave, lane);
    }
    xcd_barrier(bar);
    {
        SchedP3 S{(const char*)(ws + WS_MRG), (const char*)(ws + WS_WOUT), G, vcu};
        EpiRes<true> E{args.in[0], args.in[1], args.out, (bf16*)(ws + WS_X1B), DM, (float*)(ws + WS_SSQ1), (const float*)(ws + WS_SSQA)};
        pg8::gemm_phase<EpiRes<true>, SchedP3, true>(lds, 1024, S, E);
    }
    xcd_barrier(bar);
    {
        SchedP4 S{(const char*)(ws + WS_X1B), (const char*)(ws + WS_W1), G, vcu};
        EpiP4 E{(const float*)(ws + WS_SSQ1), (bf16*)(ws + WS_H)};
        pg8::gemm_phase<EpiP4, SchedP4, true>(lds, 1024, S, E);
    }
    xcd_barrier(bar);
    {
        SchedP5 S{(const char*)(ws + WS_H), (const char*)(ws + WS_W2), G, vcu};
        EpiRes<false> E{nullptr, nullptr, args.out, (bf16*)(ws + WS_ACAT), 1280, (float*)(ws + WS_SSQ2), nullptr};
        pg8::gemm_phase<EpiRes<false>, SchedP5, true>(lds, 4096, S, E);
    }
    xcd_barrier(bar);
    {
        SchedP6 S{(const char*)(ws + WS_ACAT), (const char*)(ws + WS_WGP), G, vcu};
        EpiP6 E{(const float*)(ws + WS_SSQ2), (bf16*)(ws + WS_PLE), args.out};
        pg8::gemm_phase<EpiP6, SchedP6, true>(lds, 1280, S, E);
    }
}

extern "C" void kernel_launch(void* const* d_in, const int* in_sizes, int n_in, void* d_out, int out_size, void* d_ws, size_t ws_size, hipStream_t stream) {
    static int grid = 0;
    if (grid == 0) {
        if (n_in != 25 || in_sizes[0] != RP * DM || (size_t)out_size != O_END || ws_size < WS_END) {
            fprintf(stderr, "kernel_launch: unexpected shapes: n_in %d in0 %d out %d ws %zu; nothing launched\n", n_in, n_in > 0 ? in_sizes[0] : -1, out_size, ws_size); grid = -1; return; }
        int dev = 0, cus = 0, per_cu = 0;
        if (hipGetDevice(&dev) != hipSuccess || hipDeviceGetAttribute(&cus, hipDeviceAttributeMultiprocessorCount, dev) != hipSuccess) { grid = -1; return; }
        if (hipFuncSetAttribute((const void*)fwd_kernel, hipFuncAttributeMaxDynamicSharedMemorySize, LDS_BYTES) != hipSuccess) { fprintf(stderr, "kernel_launch: hipFuncSetAttribute failed\n"); grid = -1; return; }
        if (hipOccupancyMaxActiveBlocksPerMultiprocessor(&per_cu, (const void*)fwd_kernel, 512, LDS_BYTES) != hipSuccess || per_cu < 1)
            fprintf(stderr, "kernel_launch: note: occupancy query reports %d workgroups per CU\n", per_cu);
        (void)hipGetLastError();
        grid = cus;
    }
    if (grid < 0) return;
    if (hipMemsetAsync((char*)d_ws + WS_CTL, 0, CTL_ZERO_BYTES, stream) != hipSuccess) return;
    Args a{};
    for (int i = 0; i < 25; ++i) a.in[i] = (const float*)d_in[i];
    a.out = (float*)d_out; a.ws = (unsigned char*)d_ws;
    hipLaunchKernelGGL(fwd_kernel, dim3(grid), dim3(512), LDS_BYTES, stream, a);
}
```

```cpp
#include <hip/hip_runtime.h>
#include <cstdio>
#include <cstdint>

#define DI __device__ __forceinline__
#define LAS __attribute__((address_space(3)))
#define GAS __attribute__((address_space(1)))
typedef unsigned short bf16;
typedef short bf16x8 __attribute__((ext_vector_type(8)));
typedef float f32x4 __attribute__((ext_vector_type(4)));
typedef float f32x2 __attribute__((ext_vector_type(2)));
typedef float f32x16 __attribute__((ext_vector_type(16)));
typedef unsigned u32x4 __attribute__((ext_vector_type(4)));
typedef unsigned u32x2 __attribute__((ext_vector_type(2)));
typedef __bf16 bf16x2_t __attribute__((ext_vector_type(2)));
typedef GAS unsigned gu32;

constexpr int DM = 1024, NB = 8, SEQ = 2048, DSEQ = 64, DCONV = 512, DATT = 512, NH = 8, HD = 64, CW = 31, DFF = 4096, DPLE = 256, DIN = 2560;
constexpr int RP = NB * SEQ, RS = NB * DSEQ, R = RP + RS;
constexpr int KEEP = 512, CST = CW - 1;
constexpr float EPS = 1e-6f;
constexpr float LOG2E = 1.4426950408889634f;
constexpr float C2 = 0.125f * LOG2E;
constexpr size_t O_YP = 0, O_YS = (size_t)RP * DM, O_KP = O_YS + (size_t)RS * DM, O_VP = O_KP + (size_t)NB * KEEP * DATT, O_CP = O_VP + (size_t)NB * KEEP * DATT,
                 O_KS = O_CP + (size_t)NB * CST * DCONV, O_VS = O_KS + (size_t)RS * DATT, O_CS = O_VS + (size_t)RS * DATT, O_END = O_CS + (size_t)NB * CST * DCONV;
constexpr size_t MiB = 1u << 20;
constexpr size_t WS_CTL = 0, CTL_ZERO_BYTES = 64 * 1024;
constexpr size_t WS_RMIX = 1 * MiB;
constexpr size_t WS_SSQA = WS_RMIX + 128 * 1024;
constexpr size_t WS_SSQ1 = 2 * MiB;
constexpr size_t WS_SSQ2 = 4 * MiB;
constexpr size_t WS_SSQS1 = 5 * MiB + 512 * 1024, WS_SSQS2 = WS_SSQS1 + 128 * 1024;
constexpr size_t WS_WIN = 6 * MiB, WS_WOUT = 11 * MiB, WS_W1 = 13 * MiB, WS_W2 = 21 * MiB, WS_WGP = 29 * MiB;
constexpr size_t WS_ACAT = 32 * MiB;
constexpr size_t WS_X1B = 74 * MiB;
constexpr size_t WS_KC = WS_X1B, WS_VCT = WS_X1B + 4 * MiB, WS_VTS = WS_X1B + 8 * MiB, WS_PLE = WS_X1B;
constexpr size_t WS_H = 107 * MiB;
constexpr size_t WS_XB = WS_H, WS_UB = WS_XB + 33 * MiB, WS_QB = WS_UB + 33 * MiB / 2, WS_KB = WS_QB + 33 * MiB / 2, WS_VTP = WS_KB + 33 * MiB / 2, WS_MRG = WS_VTP + 16 * MiB;
constexpr size_t WS_END = 256 * MiB;
static_assert(WS_MRG + (size_t)R * DM * 2 <= WS_H + (size_t)R * DFF * 2 && WS_H + (size_t)R * DFF * 2 <= WS_END, "d_ws map");
static_assert(WS_ACAT + (size_t)R * 1280 * 2 <= WS_X1B && WS_X1B + (size_t)R * DM * 2 <= WS_H, "d_ws map 2");
constexpr int CW_BAR = 1024;

DI unsigned cvtpk(float lo, float hi) { f32x2 v = {lo, hi}; bf16x2_t b = __builtin_convertvector(v, bf16x2_t); return __builtin_bit_cast(unsigned, b); }
DI float bf2f(unsigned short h) { return __uint_as_float((unsigned)h << 16); }
DI float sigmoidf_(float x) { return __builtin_amdgcn_rcpf(1.f + __builtin_amdgcn_exp2f(-LOG2E * x)); }
DI float wave_sum(float v) {
#pragma unroll
    for (int o = 1; o < 64; o <<= 1) v += __shfl_xor(v, o);
    return v;
}
#define LDS_WAIT() asm volatile("s_waitcnt lgkmcnt(0)" ::: "memory")
#define VM_WAIT() asm volatile("s_waitcnt vmcnt(0)" ::: "memory")

namespace pg8 {
constexpr int BM = 256, BK = 64, HALF = 128, HTB = HALF * BK * 2, STAGE_BYTES = 8 * HTB;
__host__ __device__ __forceinline__ int lds_byte(int r, int c) { const int st = (r >> 4) * 2 + (c >> 5), rr = r & 15, cc = c & 31, ob = rr * 64 + cc * 2; return st * 1024 + (ob ^ (((ob >> 9) & 1) << 5)); }
__host__ __device__ __forceinline__ void stage_rc(int b, int& R_, int& C) { const int st = b / 1024, sb = b % 1024, swz = sb ^ (((sb >> 9) & 1) << 5); R_ = (st >> 1) * 16 + swz / 64; C = (st & 1) * 32 + (swz % 64) / 2; }
__host__ __device__ __forceinline__ int perm32(int rho) { const int n = rho >> 4, i = rho & 15; return 8 * (i >> 2) + 4 * n + (i & 3); }

struct Unit { const char* A; const char* B; int nt; int kind; int pm; int pn; };

template <class Epi, class Sched, bool ALIGN_EPI>
DI void gemm_phase(LAS unsigned char* lds, const int pitch, const Sched& S, const Epi& E) {
    int tid = threadIdx.x; asm volatile("" : "+v"(tid));
    const int wid = __builtin_amdgcn_readfirstlane(tid >> 6), lane = tid & 63, wr = wid >> 2, wc = wid & 3, fr = lane & 15, fq = lane >> 4;
    unsigned voffA[2], voffB[2];
#pragma unroll
    for (int i = 0; i < 2; ++i) { int R_, C; stage_rc(tid * 16 + i * 8192, R_, C); const int Rb = (R_ & ~31) + perm32(R_ & 31);
        voffA[i] = (unsigned)(R_ * pitch + C) * 2u; voffB[i] = (unsigned)(Rb * pitch + C) * 2u; }
    const size_t kstep = (size_t)(BK * 2);
    const size_t hstep = (size_t)HALF * pitch * 2;
    const unsigned ldsw = (unsigned)wid * 1024u;
    const int aoff = lds_byte(wr * 64 + fr, fq * 8), boff = lds_byte(wc * 32 + fr, fq * 8);
#define PG8_SA(b, h) (((b) * 2 + (h)) * HTB)
#define PG8_SB(b, h) ((4 + (b) * 2 + (h)) * HTB)
#define PG8_STAGE(bufoff, gbase, voff) do { _Pragma("unroll") for (int _i = 0; _i < 2; ++_i) \
        __builtin_amdgcn_global_load_lds((const unsigned*)((const char*)(gbase) + (voff)[_i]), (LAS unsigned*)(lds + (bufoff) + ldsw + _i * 8192), 16, 0, 0); } while (0)
#define PG8_LDA(dst, b, h) do { _Pragma("unroll") for (int m = 0; m < 4; ++m) _Pragma("unroll") for (int k = 0; k < 2; ++k) dst[m][k] = *(const LAS bf16x8*)(lds + PG8_SA(b, h) + aoff + m * 2048 + k * 1024); } while (0)
#define PG8_LDB(dst, b, h) do { _Pragma("unroll") for (int n = 0; n < 2; ++n) _Pragma("unroll") for (int k = 0; k < 2; ++k) dst[n][k] = *(const LAS bf16x8*)(lds + PG8_SB(b, h) + boff + n * 2048 + k * 1024); } while (0)
#define PG8_MMA(ai, bj, At, Bt) do { __builtin_amdgcn_s_setprio(1); _Pragma("unroll") for (int m = 0; m < 4; ++m) _Pragma("unroll") for (int n = 0; n < 2; ++n) _Pragma("unroll") for (int k = 0; k < 2; ++k) \
        acc[ai][bj][m][n] = __builtin_amdgcn_mfma_f32_16x16x32_bf16(Bt[n][k], At[m][k], acc[ai][bj][m][n], 0, 0, 0); __builtin_amdgcn_s_setprio(0); } while (0)
#define PG8_WAIT_V(n) asm volatile("s_waitcnt vmcnt(" #n ")" ::: "memory")
#define PG8_WAIT_L(n) asm volatile("s_waitcnt lgkmcnt(" #n ")" ::: "memory")
#define PG8_BAR __builtin_amdgcn_s_barrier()
#define PG8_SCHED __builtin_amdgcn_sched_barrier(0)
    Unit cur, nxt; int ui = 0;
    if (!S.next(0, cur)) return;
    f32x4 acc[2][2][4][2];
#pragma unroll
    for (int a = 0; a < 2; ++a)
#pragma unroll
        for (int b = 0; b < 2; ++b)
#pragma unroll
            for (int m = 0; m < 4; ++m)
#pragma unroll
                for (int n = 0; n < 2; ++n) acc[a][b][m][n] = (f32x4){0.f, 0.f, 0.f, 0.f};
    bf16x8 At[4][2], B0[2][2], B1[2][2];
    const char* cA = cur.A; const char* cB = cur.B;
    E.a_ready(cur, 0, lds);
    PG8_STAGE(PG8_SB(0, 0), cB, voffB); PG8_STAGE(PG8_SB(0, 1), cB + hstep, voffB); PG8_STAGE(PG8_SA(0, 0), cA, voffA); PG8_STAGE(PG8_SA(0, 1), cA + hstep, voffA);
    if (wr == 1) PG8_BAR;
    PG8_WAIT_V(2); PG8_BAR;
    PG8_STAGE(PG8_SB(1, 0), cB + kstep, voffB); PG8_STAGE(PG8_SA(1, 0), cA + kstep, voffA); PG8_STAGE(PG8_SB(1, 1), cB + hstep + kstep, voffB);
    PG8_WAIT_V(6); PG8_BAR;
    for (;;) {
        const bool has_next = S.next(ui + 1, nxt);
        const char* nA = has_next ? nxt.A : cA; const char* nB = has_next ? nxt.B : cB;
        const int nt = cur.nt;
        for (int t = 0; t < nt; t += 2) {
            const bool last = (t == nt - 2);
            if constexpr (Epi::HAS_MID) { if (t == Epi::MID_T) E.mid(acc, cur, ui, wr, wc, fr, fq, lds); }
            const char* a1 = cA + (size_t)(t + 1) * kstep;
            const char* a2 = last ? nA : cA + (size_t)(t + 2) * kstep; const char* b2 = last ? nB : cB + (size_t)(t + 2) * kstep;
            const char* a3 = a2 + kstep; const char* b3 = b2 + kstep;
            if (last && has_next) E.a_ready(nxt, ui + 1, lds);
            PG8_LDB(B0, 0, 0); PG8_LDB(B1, 0, 1); PG8_SCHED; PG8_LDA(At, 0, 0); PG8_STAGE(PG8_SA(1, 1), a1 + hstep, voffA);
            PG8_WAIT_V(8); PG8_WAIT_L(0); PG8_BAR; PG8_MMA(0, 0, At, B0); PG8_MMA(0, 1, At, B1); PG8_BAR; PG8_SCHED;
            PG8_LDA(At, 0, 1); PG8_STAGE(PG8_SB(0, 0), b2, voffB); PG8_STAGE(PG8_SB(0, 1), b2 + hstep, voffB); PG8_STAGE(PG8_SA(0, 0), a2, voffA);
            PG8_WAIT_V(8); PG8_WAIT_L(0); PG8_BAR; PG8_MMA(1, 0, At, B0); PG8_MMA(1, 1, At, B1); PG8_BAR; PG8_SCHED;
            PG8_LDB(B0, 1, 0); PG8_LDB(B1, 1, 1); PG8_SCHED; PG8_LDA(At, 1, 0); PG8_STAGE(PG8_SA(0, 1), a2 + hstep, voffA);
            PG8_WAIT_V(8); PG8_WAIT_L(0); PG8_BAR; PG8_MMA(0, 0, At, B0); PG8_MMA(0, 1, At, B1); PG8_BAR; PG8_SCHED;
            PG8_LDA(At, 1, 1); PG8_STAGE(PG8_SB(1, 0), b3, voffB); PG8_STAGE(PG8_SB(1, 1), b3 + hstep, voffB); PG8_STAGE(PG8_SA(1, 0), a3, voffA);
            PG8_WAIT_V(8); PG8_WAIT_L(0); PG8_BAR; PG8_MMA(1, 0, At, B0); PG8_MMA(1, 1, At, B1); PG8_BAR; PG8_SCHED;
        }
        if constexpr (ALIGN_EPI) { if (wr == 0) PG8_BAR; }
        E(acc, cur, ui, wr, wc, fr, fq, lds);
        if (!has_next) break;
#pragma unroll
        for (int a = 0; a < 2; ++a)
#pragma unroll
            for (int b = 0; b < 2; ++b)
#pragma unroll
                for (int m = 0; m < 4; ++m)
#pragma unroll
                    for (int n = 0; n < 2; ++n) acc[a][b][m][n] = (f32x4){0.f, 0.f, 0.f, 0.f};
        cur = nxt; cA = nA; cB = nB; ++ui;
        if constexpr (ALIGN_EPI) { if (wr == 1) PG8_BAR; }
    }
    PG8_WAIT_V(0);
    if constexpr (!ALIGN_EPI) { if (wr == 0) PG8_BAR; }
    PG8_BAR;
#undef PG8_SA
#undef PG8_SB
#undef PG8_STAGE
#undef PG8_LDA
#undef PG8_LDB
#undef PG8_MMA
#undef PG8_WAIT_V
#undef PG8_WAIT_L
#undef PG8_BAR
#undef PG8_SCHED
}
}

#define XB_TMO      128
#define XB_XCNT(j)  (256  + 64 * (j))
#define XB_XSUB(j)  (1280 + 64 * (j))
#define XB_XGEN(j)  (2304 + 64 * (j))
#define XB_TOP      3328
#define XB_TOPGEN   3392
#define XCD_BAR_WORDS 3456
#define XB_SPIN_CAP (1u << 18)
DI unsigned xb_ld(unsigned* p)              { return __hip_atomic_load(p, __ATOMIC_RELAXED, __HIP_MEMORY_SCOPE_AGENT); }
DI unsigned xb_add(unsigned* p, unsigned v) { return __hip_atomic_fetch_add(p, v, __ATOMIC_RELAXED, __HIP_MEMORY_SCOPE_AGENT); }
DI unsigned xb_xcc_id() { return (unsigned)__builtin_amdgcn_s_getreg((3 << 11) | 20) & 0xFu; }
#define XB_SPIN(cond, bar) do { unsigned _sp = 0; while (cond) { __builtin_amdgcn_s_sleep(1); \
    if ((++_sp & 255u) == 0u) { if (xb_ld(&(bar)[XB_TMO])) break; if (_sp > XB_SPIN_CAP) { atomicAdd(&(bar)[XB_TMO], 1u); break; } } } } while (0)
struct XcdBarrier { unsigned* bar; unsigned x; volatile LAS unsigned* st; };
DI XcdBarrier xcd_barrier_post(unsigned* bar, volatile LAS unsigned* st) {
    XcdBarrier b; b.bar = bar; b.x = xb_xcc_id(); b.st = st;
    if (threadIdx.x == 0) (void)xb_add(&bar[XB_XCNT(b.x)], 1u);
    return b;
}
DI void xcd_barrier_complete(unsigned* bar, unsigned x, unsigned& nloc, unsigned& nx) {
    const unsigned G = gridDim.x * gridDim.y * gridDim.z;
    unsigned sum, cnt, mine, sp = 0u;
    for (;;) {
        sum = 0u; cnt = 0u; mine = 0u;
#pragma unroll
        for (unsigned j = 0; j < 16; ++j) { const unsigned c = xb_ld(&bar[XB_XCNT(j)]); sum += c; cnt += (c > 0u) ? 1u : 0u; mine = (j == x) ? c : mine; }
        if (sum == G) break;
        __builtin_amdgcn_s_sleep(1);
        if ((++sp & 255u) == 0u) { if (xb_ld(&bar[XB_TMO])) break; if (sp > XB_SPIN_CAP) { atomicAdd(&bar[XB_TMO], 1u); break; } }
    }
    nloc = mine > 0u ? mine : 1u; nx = cnt > 0u ? cnt : 1u;
}
DI void xcd_barrier(const XcdBarrier& b) {
    asm volatile("s_waitcnt vmcnt(0)" ::: "memory");
    __syncthreads();
    if (threadIdx.x == 0) {
        unsigned* bar = b.bar;
        __builtin_amdgcn_s_waitcnt(0);
        unsigned nloc = b.st[0], nx = b.st[1];
        if (nloc == 0u) { xcd_barrier_complete(bar, b.x, nloc, nx); b.st[0] = nloc; b.st[1] = nx; }
        const unsigned old = xb_add(&bar[XB_XSUB(b.x)], 1u);
        const unsigned gen = old / nloc;
        if (old + 1u == (gen + 1u) * nloc) {
            __builtin_amdgcn_fence(__ATOMIC_RELEASE, "agent");
            asm volatile("s_waitcnt vmcnt(0)" ::: "memory");
            const unsigned og = xb_add(&bar[XB_TOP], 1u);
            const unsigned tg = og / nx;
            if (og + 1u == (tg + 1u) * nx) xb_add(&bar[XB_TOPGEN], 1u);
            else XB_SPIN(xb_ld(&bar[XB_TOPGEN]) == tg, bar);
            __builtin_amdgcn_fence(__ATOMIC_ACQUIRE, "agent");
            xb_add(&bar[XB_XGEN(b.x)], 1u);
            asm volatile("s_waitcnt vmcnt(0)" ::: "memory");
        } else {
            XB_SPIN(xb_ld(&bar[XB_XGEN(b.x)]) == gen, bar);
            __builtin_amdgcn_fence(__ATOMIC_ACQUIRE, "agent");
            asm volatile("s_waitcnt vmcnt(0)" ::: "memory");
        }
    }
    __syncthreads();
}

constexpr int RING_BYTES = 131072;
constexpr int RTAB_OFF = RING_BYTES;
constexpr int MISC_OFF = RING_BYTES + 2048;
constexpr int LDS_BYTES = 147456;

struct Args {
    const float* in[25]; float* out; unsigned char* ws; int pad0, pad1;
};

struct Frame {
    LAS unsigned char* lds; int tid, lane, wave, vcu, G;
    const float* const* dummy;
};

DI void p0_transpose_item(const float* W, int ldw, int k0s, int n0s, const float* gain, bf16* WT, int pitch, int n0d, int k0d, bool perm16, LAS float* scr, int lane) {
#pragma unroll 8
    for (int i = 0; i < 32; ++i) { const int kk = 2 * i + (lane >> 5); float v = W[(size_t)(k0s + kk) * ldw + n0s + (lane & 31)]; if (gain) v *= gain[k0s + kk]; scr[kk * 33 + (lane & 31)] = v; }
    LDS_WAIT(); asm volatile("" ::: "memory");
    const int c = lane & 7;
#pragma unroll
    for (int j = 0; j < 4; ++j) { const int n = (lane >> 3) + 8 * j;
        float e[8];
#pragma unroll
        for (int q = 0; q < 8; ++q) { const int kk = perm16 ? (16 * (c >> 1) + 8 * (q >> 2) + 4 * (c & 1) + (q & 3)) : (8 * c + q); e[q] = scr[kk * 33 + n]; }
        u32x4 o; o.x = cvtpk(e[0], e[1]); o.y = cvtpk(e[2], e[3]); o.z = cvtpk(e[4], e[5]); o.w = cvtpk(e[6], e[7]);
        *(GAS u32x4*)(WT + (size_t)(n0d + n) * pitch + k0d + 8 * c) = o; }
    LDS_WAIT(); asm volatile("" ::: "memory");
}
DI int win_src_col(int nd) {
    if (nd < 1024) { const int pn = nd >> 8, bj = (nd >> 7) & 1, x = nd & 127; return bj * 512 + 128 * pn + x; }
    if (nd < 2048) { const int rel = nd - 1024, kq = rel >> 9, rr = rel & 511, tp = rr >> 8, bj = (rr >> 7) & 1, wc = (rr >> 5) & 3, y = rr & 31; return 1024 + 512 * kq + 64 * (4 * tp + wc) + 32 * bj + y; }
    return nd;
}
DI void p0_prep(const Args& a, LAS unsigned char* lds, int vcu, int G, int wave, int lane) {
    asm volatile("" : "+v"(lane));
    LAS float* scr = (LAS float*)(lds + wave * 16384);
    unsigned char* ws = a.ws;
    const int gw = vcu * 8 + wave, NGW = G * 8;
    bf16* Win_t = (bf16*)(ws + WS_WIN); bf16* Wout_t = (bf16*)(ws + WS_WOUT); bf16* W1_t = (bf16*)(ws + WS_W1); bf16* W2_t = (bf16*)(ws + WS_W2); bf16* Wgp_t = (bf16*)(ws + WS_WGP);
    constexpr int I_IN = 16 * 80, I_OUT = 16 * 32, I_1 = 16 * 128, I_2 = 64 * 32, I_G = 16 * 32, I_P = 4 * 32, I_V = 8 * 8 * 16;
    constexpr int NIT = I_IN + I_OUT + I_1 + I_2 + I_G + I_P + I_V;
    for (int it = gw; it < NIT; it += NGW) {
        int r = it;
        if (r < I_IN) { const int kb = r / 80, nb = r % 80; p0_transpose_item(a.in[8], DIN, 64 * kb, win_src_col(32 * nb), a.in[7], Win_t, 1024, 32 * nb, 64 * kb, false, scr, lane); continue; } r -= I_IN;
        if (r < I_OUT) { const int kb = r / 32, nb = r % 32; const int k0 = 64 * kb; const float* gain = (k0 < 512) ? a.in[16] : (a.in[17] - 512);
            p0_transpose_item(a.in[18], DM, k0, 32 * nb, gain, Wout_t, 1024, 32 * nb, (k0 + 512) & 1023, false, scr, lane); continue; } r -= I_OUT;
        if (r < I_1) { const int kb = r / 128, nb = r % 128; p0_transpose_item(a.in[20], DFF, 64 * kb, 32 * nb, a.in[19], W1_t, 1024, 32 * nb, 64 * kb, false, scr, lane); continue; } r -= I_1;
        if (r < I_2) { const int kb = r / 32, nb = r % 32; p0_transpose_item(a.in[21], DM, 64 * kb, 32 * nb, nullptr, W2_t, 4096, 32 * nb, 64 * kb, false, scr, lane); continue; } r -= I_2;
        if (r < I_G) { const int kb = r / 32, nb = r % 32; p0_transpose_item(a.in[23], DM, 64 * kb, 32 * nb, a.in[22], Wgp_t, 1280, 32 * nb, 64 * kb, false, scr, lane); continue; } r -= I_G;
        if (r < I_P) { const int kb = r / 32, nb = r % 32; p0_transpose_item(a.in[24], DM, 64 * kb, 32 * nb, nullptr, Wgp_t, 1280, 32 * nb, 1024 + 64 * kb, false, scr, lane); continue; } r -= I_P;
        { const int b = r / 128, rr = r % 128, kb = rr / 16, nb = rr % 16;
          p0_transpose_item(a.in[5] + (size_t)b * KEEP * DATT, DATT, 64 * kb, 32 * nb, nullptr, (bf16*)(ws + WS_VCT) + (size_t)b * DATT * KEEP, KEEP, 32 * nb, 64 * kb, true, scr, lane); }
    }
    bf16* xb = (bf16*)(ws + WS_XB); float* rmix = (float*)(ws + WS_RMIX); bf16* acat = (bf16*)(ws + WS_ACAT); bf16* kc = (bf16*)(ws + WS_KC);
    for (int m = gw; m < R; m += NGW) {
        const float* xrow = (m < RP) ? a.in[0] + (size_t)m * DM : a.in[1] + (size_t)(m - RP) * DM;
        const GAS f32x4* xr = (const GAS f32x4*)xrow + lane;
        f32x4 v[4]; float s = 0.f;
#pragma unroll
        for (int j = 0; j < 4; ++j) { v[j] = xr[64 * j]; s += (v[j].x * v[j].x + v[j].y * v[j].y) + (v[j].z * v[j].z + v[j].w * v[j].w); }
        s = wave_sum(s);
        if (lane == 0) rmix[m] = 1.0f / sqrtf(s * (1.f / DM) + EPS);
        GAS u32x2* o8 = (GAS u32x2*)(xb + (size_t)m * DM) + lane;
#pragma unroll
        for (int j = 0; j < 4; ++j) { u32x2 w; w.x = cvtpk(v[j].x, v[j].y); w.y = cvtpk(v[j].z, v[j].w); o8[64 * j] = w; }
        const float* prow = (m < RP) ? a.in[2] + (size_t)m * DPLE : a.in[3] + (size_t)(m - RP) * DPLE;
        const f32x4 pv = ((const GAS f32x4*)prow)[lane];
        u32x2 w; w.x = cvtpk(pv.x, pv.y); w.y = cvtpk(pv.z, pv.w);
        *((GAS u32x2*)(acat + (size_t)m * 1280 + 1024) + lane) = w;
    }
    for (int m = gw; m < NB * KEEP; m += NGW) {
        const GAS f32x4* kr = (const GAS f32x4*)(a.in[4] + (size_t)m * DATT) + lane;
        const f32x4 v0 = kr[0], v1 = kr[64];
        GAS u32x2* o8 = (GAS u32x2*)(kc + (size_t)m * DATT) + lane;
        u32x2 w0, w1; w0.x = cvtpk(v0.x, v0.y); w0.y = cvtpk(v0.z, v0.w); w1.x = cvtpk(v1.x, v1.y); w1.y = cvtpk(v1.z, v1.w);
        o8[0] = w0; o8[64] = w1;
    }
}

struct SchedP1 {
    const char* xb; const char* win; int G, vcu;
    DI bool next(int i, pg8::Unit& u) const {
        const int L = i * G + vcu; if (L >= 660) return false;
        const int T = L / 10, j = L % 10;
        if (j < 8) { u.A = xb + (size_t)T * 256 * 2048; u.B = win + (size_t)j * 256 * 2048; u.kind = (j < 4) ? 0 : (j < 6 ? 1 : 2); u.pm = T; u.pn = j; }
        else { u.A = win + (size_t)(8 + (j - 8)) * 256 * 2048; u.B = xb + (size_t)T * 256 * 2048; u.kind = 3; u.pm = j - 8; u.pn = T; }
        u.nt = 16; return true;
    }
};
struct EpiP1 {
    static constexpr bool HAS_MID = false; static constexpr int MID_T = -1;
    const float* rmix; bf16* ub; bf16* qb; bf16* kb; bf16* vtp; bf16* vts; float* out; const float* gq; const float* gk;
    DI void a_ready(const pg8::Unit&, int, LAS unsigned char*) const {}
    DI void mid(f32x4 (&)[2][2][4][2], const pg8::Unit&, int, int, int, int, int, LAS unsigned char*) const {}
    DI void operator()(const f32x4 (&acc)[2][2][4][2], const pg8::Unit& u, int, int wr, int wc, int fr, int fq, LAS unsigned char*) const {
        if (u.kind == 0) {
            const int ch0 = 128 * u.pn + 32 * wc + 8 * fq;
#pragma unroll
            for (int ai = 0; ai < 2; ++ai)
#pragma unroll
                for (int m = 0; m < 4; ++m) {
                    const int row = u.pm * 256 + ai * 128 + wr * 64 + m * 16 + fr; const float r = rmix[row];
                    f32x4 v[2];
#pragma unroll
                    for (int n = 0; n < 2; ++n) { const f32x4 a_ = acc[ai][0][m][n] * r, g_ = acc[ai][1][m][n] * r;
                        v[n] = (f32x4){a_[0] * sigmoidf_(g_[0]), a_[1] * sigmoidf_(g_[1]), a_[2] * sigmoidf_(g_[2]), a_[3] * sigmoidf_(g_[3])}; }
                    u32x4 w; w.x = cvtpk(v[0][0], v[0][1]); w.y = cvtpk(v[0][2], v[0][3]); w.z = cvtpk(v[1][0], v[1][1]); w.w = cvtpk(v[1][2], v[1][3]);
                    *(u32x4*)(ub + (size_t)row * DCONV + ch0) = w;
                    int orow = -1; size_t obase = 0;
                    if (row < RP) { const int b = row >> 11, t = row & 2047; if (t >= SEQ - CST) { orow = b * CST + (t - (SEQ - CST)); obase = O_CP; } }
                    else { const int rs = row - RP, b = rs >> 6, t = rs & 63; if (t >= DSEQ - CST) { orow = b * CST + (t - (DSEQ - CST)); obase = O_CS; } }
                    if (orow >= 0) { float* o = out + obase + (size_t)orow * DCONV + ch0; *(f32x4*)o = v[0]; *(f32x4*)(o + 4) = v[1]; }
                }
        } else if (u.kind == 3) {
            const int T = u.pn;
            f32x4 rv[2][2];
#pragma unroll
            for (int bj = 0; bj < 2; ++bj)
#pragma unroll
                for (int n = 0; n < 2; ++n) rv[bj][n] = *(const f32x4*)(rmix + T * 256 + bj * 128 + wc * 32 + 8 * fq + 4 * n);
#pragma unroll
            for (int ai = 0; ai < 2; ++ai)
#pragma unroll
                for (int m = 0; m < 4; ++m) {
                    const int vcol = u.pm * 256 + ai * 128 + wr * 64 + m * 16 + fr;
#pragma unroll
                    for (int bj = 0; bj < 2; ++bj)
#pragma unroll
                        for (int n = 0; n < 2; ++n) {
                            const f32x4 v = acc[ai][bj][m][n] * rv[bj][n];
                            u32x2 w; w.x = cvtpk(v[0], v[1]); w.y = cvtpk(v[2], v[3]);
                            const int slot = 16 * (fq >> 1) + 4 * (2 * n + (fq & 1));
                            if (T < 64) { const int b = T >> 3, t0 = (T & 7) * 256 + bj * 128 + wc * 32;
                                *(u32x2*)(vtp + ((size_t)(b * DATT + vcol) * SEQ + t0 + slot)) = w;
                                if ((T & 7) >= 6) { const int t = t0 + 8 * fq + 4 * n - (SEQ - KEEP); float* o = out + O_VP + ((size_t)(b * KEEP + t) * DATT + vcol);
                                    o[0] = v[0]; o[DATT] = v[1]; o[2 * DATT] = v[2]; o[3 * DATT] = v[3]; } }
                            else { const int tk0 = (T - 64) * 256 + bj * 128 + wc * 32, b = tk0 >> 6, t0 = tk0 & 63;
                                *(u32x2*)(vts + ((size_t)(b * DATT + vcol) * DSEQ + t0 + slot)) = w;
                                float* o = out + O_VS + ((size_t)(tk0 + 8 * fq + 4 * n) * DATT + vcol);
                                o[0] = v[0]; o[DATT] = v[1]; o[2 * DATT] = v[2]; o[3 * DATT] = v[3]; }
                        }
                }
        } else {
            const bool isk = (u.kind == 2);
            const float* g = isk ? gk : gq; bf16* dst = isk ? kb : qb;
            const int hd = 4 * (u.pn & 1) + wc;
            f32x4 gv[2][2];
#pragma unroll
            for (int bj = 0; bj < 2; ++bj)
#pragma unroll
                for (int n = 0; n < 2; ++n) gv[bj][n] = *(const f32x4*)(g + 32 * bj + 8 * fq + 4 * n);
#pragma unroll
            for (int ai = 0; ai < 2; ++ai)
#pragma unroll
                for (int m = 0; m < 4; ++m) {
                    const int row = u.pm * 256 + ai * 128 + wr * 64 + m * 16 + fr; const float r = rmix[row];
                    float ss = 0.f;
#pragma unroll
                    for (int bj = 0; bj < 2; ++bj)
#pragma unroll
                        for (int n = 0; n < 2; ++n) { const f32x4 x = acc[ai][bj][m][n]; ss += (x[0] * x[0] + x[1] * x[1]) + (x[2] * x[2] + x[3] * x[3]); }
                    ss += __shfl_xor(ss, 16); ss += __shfl_xor(ss, 32);
                    float rs = r / sqrtf(ss * r * r * (1.f / HD) + EPS);
                    if (!isk) rs *= C2;
                    int orow = -1; size_t obase = 0;
                    if (isk) { if (row < RP) { const int b = row >> 11, t = row & 2047; if (t >= SEQ - KEEP) { orow = b * KEEP + (t - (SEQ - KEEP)); obase = O_KP; } } else { orow = row - RP; obase = O_KS; } }
#pragma unroll
                    for (int bj = 0; bj < 2; ++bj) {
                        const f32x4 v0 = acc[ai][bj][m][0] * rs * gv[bj][0], v1 = acc[ai][bj][m][1] * rs * gv[bj][1];
                        u32x4 w; w.x = cvtpk(v0[0], v0[1]); w.y = cvtpk(v0[2], v0[3]); w.z = cvtpk(v1[0], v1[1]); w.w = cvtpk(v1[2], v1[3]);
                        const int col = hd * HD + 32 * bj + 8 * fq;
                        *(u32x4*)(dst + (size_t)row * DATT + col) = w;
                        if (orow >= 0) { float* o = out + obase + (size_t)orow * DATT + col; *(f32x4*)o = v0; *(f32x4*)(o + 4) = v1; }
                    }
                }
        }
    }
};


constexpr int AT_KS = 0, AT_KPITCH = 528, AT_VS = 64 * AT_KPITCH, AT_VPITCH = 144, AT_BIAS = AT_VS + 256 * AT_VPITCH, AT_BIASP = 260, AT_OST = AT_BIAS + 4 * AT_BIASP * 4 + 64, AT_OPITCH = 144;
static_assert(AT_OST % 16 == 0 && AT_OST + 8 * 32 * AT_OPITCH <= RING_BYTES, "attention LDS map");
DI int crow(int reg, int hi) { return (reg & 3) + 8 * (reg >> 2) + 4 * hi; }
DI bf16x8 pack8(const f32x16& x, int s) {
    u32x4 p; p.x = cvtpk(x[8 * s], x[8 * s + 1]); p.y = cvtpk(x[8 * s + 2], x[8 * s + 3]); p.z = cvtpk(x[8 * s + 4], x[8 * s + 5]); p.w = cvtpk(x[8 * s + 6], x[8 * s + 7]);
    return __builtin_bit_cast(bf16x8, p);
}
DI void attn_unit(const Args& a, LAS unsigned char* lds, int cidx, int hg, int tid, int wave, int lane) {
    asm volatile("" : "+v"(tid), "+v"(lane));
    unsigned char* ws = a.ws;
    const bf16* Qb = (const bf16*)(ws + WS_QB); const bf16* Kb = (const bf16*)(ws + WS_KB); const bf16* VTp = (const bf16*)(ws + WS_VTP); const bf16* VTs = (const bf16*)(ws + WS_VTS);
    const bf16* Kc = (const bf16*)(ws + WS_KC); const bf16* VcT = (const bf16*)(ws + WS_VCT); bf16* mrg = (bf16*)(ws + WS_MRG); float* ssqa = (float*)(ws + WS_SSQA);
    const bool smp = cidx >= 256; const int b = smp ? cidx - 256 : cidx >> 5, n = smp ? 8 : (cidx & 31);
    const int row0 = smp ? RP + 64 * b : b * SEQ + 64 * n;
    const int j0 = smp ? 0 : (n >= 8 ? 0 : 8 - n);
    const int hl = wave >> 1, qh = wave & 1, c = lane & 31, hi = lane >> 5, head = 4 * hg + hl;
    LAS float* biasl = (LAS float*)(lds + AT_BIAS);
    for (int i = tid; i < 4 * 257; i += 512) { const int h4 = i / 257, ii = i % 257; biasl[h4 * AT_BIASP + ii] = a.in[15][(4 * hg + h4) * 257 + ii] * LOG2E; }
    bf16x8 qf[4];
    { const bf16* qp = Qb + (size_t)(row0 + 32 * qh + c) * DATT + head * HD + 8 * hi;
#pragma unroll
      for (int s = 0; s < 4; ++s) qf[s] = *(const bf16x8*)(qp + 16 * s); }
    f32x16 ot0 = {}, ot1 = {};
    float m_run = -1e30f, l_run = 0.f;
    u32x4 kreg[4], vreg[4];
    auto issue = [&](int j) {
        const bf16* kp; size_t kpitch; const bf16* vp; size_t vpitch;
        if (!smp) { const int kc = n - 8 + j; kp = Kb + (size_t)(b * SEQ + 64 * kc) * DATT + hg * 256; kpitch = DATT; vp = VTp + (size_t)(b * DATT + hg * 256) * SEQ + 64 * kc; vpitch = SEQ; }
        else if (j < 8) { kp = Kc + (size_t)(b * KEEP + 64 * j) * DATT + hg * 256; kpitch = DATT; vp = VcT + (size_t)(b * DATT + hg * 256) * KEEP + 64 * j; vpitch = KEEP; }
        else { kp = Kb + (size_t)(RP + 64 * b) * DATT + hg * 256; kpitch = DATT; vp = VTs + (size_t)(b * DATT + hg * 256) * DSEQ; vpitch = DSEQ; }
#pragma unroll
        for (int i = 0; i < 4; ++i) { const int id = tid + 512 * i;
            kreg[i] = *(const u32x4*)(kp + (size_t)(id >> 5) * kpitch + (id & 31) * 8);
            vreg[i] = *(const u32x4*)(vp + (size_t)(id >> 3) * vpitch + (id & 7) * 8); }
    };
    issue(j0);
    for (int j = j0; j < 9; ++j) {
#pragma unroll
        for (int i = 0; i < 4; ++i) { const int id = tid + 512 * i;
            *(LAS u32x4*)(lds + AT_KS + (id >> 5) * AT_KPITCH + (id & 31) * 16) = kreg[i];
            *(LAS u32x4*)(lds + AT_VS + (id >> 3) * AT_VPITCH + (id & 7) * 16) = vreg[i]; }
        __syncthreads();
        if (j < 8) issue(j + 1);
        f32x16 st0 = {}, st1 = {};
        { const LAS unsigned char* kb0 = lds + AT_KS + c * AT_KPITCH + hl * 128 + hi * 16;
#pragma unroll
          for (int s = 0; s < 4; ++s) {
              const bf16x8 k0 = *(const LAS bf16x8*)(kb0 + s * 32);
              const bf16x8 k1 = *(const LAS bf16x8*)(kb0 + 32 * AT_KPITCH + s * 32);
              st0 = __builtin_amdgcn_mfma_f32_32x32x16_bf16(k0, qf[s], st0, 0, 0, 0);
              st1 = __builtin_amdgcn_mfma_f32_32x32x16_bf16(k1, qf[s], st1, 0, 0, 0); } }
        if (j <= 5) { const float b0 = biasl[hl * AT_BIASP];
#pragma unroll
            for (int r = 0; r < 16; ++r) { st0[r] += b0; st1[r] += b0; } }
        else { const int base = 64 * (j - 6) - (32 * qh + c) + 4 * hi; const LAS float* bl = biasl + hl * AT_BIASP;
#pragma unroll
            for (int r = 0; r < 16; ++r) { const int i0 = base + (r & 3) + 8 * (r >> 2); const int i1 = i0 + 32;
                st0[r] += bl[i0 > 0 ? i0 : 0]; st1[r] += bl[i1 > 0 ? i1 : 0]; } }
        float mx = st0[0];
#pragma unroll
        for (int r = 1; r < 16; ++r) mx = fmaxf(mx, st0[r]);
#pragma unroll
        for (int r = 0; r < 16; ++r) mx = fmaxf(mx, st1[r]);
        mx = fmaxf(mx, __shfl_xor(mx, 32));
        const float mnew = fmaxf(m_run, mx); const float alpha = __builtin_amdgcn_exp2f(m_run - mnew); m_run = mnew;
        float ls = 0.f;
#pragma unroll
        for (int r = 0; r < 16; ++r) { st0[r] = __builtin_amdgcn_exp2f(st0[r] - mnew); st1[r] = __builtin_amdgcn_exp2f(st1[r] - mnew); ls += st0[r] + st1[r]; }
        l_run = l_run * alpha + ls;
#pragma unroll
        for (int r = 0; r < 16; ++r) { ot0[r] *= alpha; ot1[r] *= alpha; }
        { const bf16x8 p0 = pack8(st0, 0), p1 = pack8(st0, 1), p2 = pack8(st1, 0), p3 = pack8(st1, 1);
          const LAS unsigned char* vb0 = lds + AT_VS + (hl * 64 + c) * AT_VPITCH + hi * 16;
#define AT_PV(P, KS) do { const bf16x8 v0 = *(const LAS bf16x8*)(vb0 + (KS) * 32); const bf16x8 v1 = *(const LAS bf16x8*)(vb0 + 32 * AT_VPITCH + (KS) * 32); \
              ot0 = __builtin_amdgcn_mfma_f32_32x32x16_bf16(v0, P, ot0, 0, 0, 0); ot1 = __builtin_amdgcn_mfma_f32_32x32x16_bf16(v1, P, ot1, 0, 0, 0); } while (0)
          AT_PV(p0, 0); AT_PV(p1, 1); AT_PV(p2, 2); AT_PV(p3, 3);
#undef AT_PV
        }
        __syncthreads();
    }
    const float lt = l_run + __shfl_xor(l_run, 32); const float inv = 1.0f / lt;
    float sq = 0.f;
#pragma unroll
    for (int r = 0; r < 16; ++r) { ot0[r] *= inv; ot1[r] *= inv; sq += ot0[r] * ot0[r] + ot1[r] * ot1[r]; }
    sq += __shfl_xor(sq, 32);
    if (hi == 0) ssqa[(size_t)(row0 + 32 * qh + c) * NH + head] = sq;
    LAS unsigned char* ost = lds + AT_OST + wave * (32 * AT_OPITCH);
#pragma unroll
    for (int r = 0; r < 16; r += 2) { const int d = crow(r, hi);
        *(LAS unsigned*)(ost + c * AT_OPITCH + d * 2) = cvtpk(ot0[r], ot0[r + 1]);
        *(LAS unsigned*)(ost + c * AT_OPITCH + (32 + d) * 2) = cvtpk(ot1[r], ot1[r + 1]); }
    LDS_WAIT();
#pragma unroll
    for (int i = 0; i < 4; ++i) { const int row = i * 8 + (lane >> 3), ch = lane & 7;
        const u32x4 v = *(const LAS u32x4*)(ost + row * AT_OPITCH + ch * 16);
        *(u32x4*)(mrg + (size_t)(row0 + 32 * qh + row) * DM + head * HD + ch * 8) = v; }
    LDS_WAIT();
}

DI void conv_item(const Args& a, LAS unsigned char* lds, int idx, int tid, int wave, int lane) {
    asm volatile("" : "+v"(tid), "+v"(lane));
    unsigned char* ws = a.ws;
    const bf16* ub = (const bf16*)(ws + WS_UB); bf16* mrg = (bf16*)(ws + WS_MRG);
    const bool smp = idx >= 512; const int b = smp ? (idx - 512) >> 1 : idx >> 6, t0 = smp ? 32 * ((idx - 512) & 1) : 32 * (idx & 63);
    const int rowb = smp ? RP + 64 * b : b * SEQ;
    LAS float* Y = (LAS float*)lds;
    {
        const int ch = tid;
        float win[62];
#pragma unroll
        for (int i = 0; i < 62; ++i) { const int tt = t0 - CST + i;
            float v;
            if (tt >= 0) v = bf2f(ub[(size_t)(rowb + tt) * DCONV + ch]);
            else v = smp ? a.in[6][(size_t)(b * CST + (tt + CST)) * DCONV + ch] : 0.f;
            win[i] = v; }
        float w[31];
#pragma unroll
        for (int j = 0; j < 31; ++j) w[j] = a.in[9][j * DCONV + ch];
        const float bd = a.in[10][ch];
#pragma unroll
        for (int o = 0; o < 32; ++o) { float acc = bd;
#pragma unroll
            for (int j = 0; j < 31; ++j) acc = fmaf(w[j], win[o + j], acc);
            Y[o * 512 + ch] = acc; }
    }
    __syncthreads();
    {
        const f32x4 g0 = *(const f32x4*)(a.in[11] + 8 * lane), g1 = *(const f32x4*)(a.in[11] + 8 * lane + 4);
        const f32x4 be0 = *(const f32x4*)(a.in[12] + 8 * lane), be1 = *(const f32x4*)(a.in[12] + 8 * lane + 4);
#pragma unroll
        for (int q = 0; q < 4; ++q) { const int o = 4 * wave + q;
            f32x4 y0 = *(const LAS f32x4*)(Y + o * 512 + 8 * lane), y1 = *(const LAS f32x4*)(Y + o * 512 + 8 * lane + 4);
            const float mean = wave_sum((y0[0] + y0[1]) + (y0[2] + y0[3]) + (y1[0] + y1[1]) + (y1[2] + y1[3])) * (1.f / DCONV);
            y0 = y0 - mean; y1 = y1 - mean;
            const float var = wave_sum((y0[0] * y0[0] + y0[1] * y0[1]) + (y0[2] * y0[2] + y0[3] * y0[3]) + (y1[0] * y1[0] + y1[1] * y1[1]) + (y1[2] * y1[2] + y1[3] * y1[3])) * (1.f / DCONV);
            const float rstd = 1.0f / sqrtf(var + EPS);
            y0 = y0 * rstd * g0 + be0; y1 = y1 * rstd * g1 + be1;
            float s[8]; float ss = 0.f;
#pragma unroll
            for (int e = 0; e < 4; ++e) { s[e] = y0[e] * sigmoidf_(y0[e]); s[4 + e] = y1[e] * sigmoidf_(y1[e]); }
#pragma unroll
            for (int e = 0; e < 8; ++e) ss += s[e] * s[e];
            const float rr = 1.0f / sqrtf(wave_sum(ss) * (1.f / DCONV) + EPS);
            u32x4 wv; wv.x = cvtpk(s[0] * rr, s[1] * rr); wv.y = cvtpk(s[2] * rr, s[3] * rr); wv.z = cvtpk(s[4] * rr, s[5] * rr); wv.w = cvtpk(s[6] * rr, s[7] * rr);
            *(u32x4*)(mrg + (size_t)(rowb + t0 + o) * DM + DATT + 8 * lane) = wv; }
    }
    __syncthreads();
}

DI void rtab_fill16(const float* ssqp, float scale_n, int pm, int ui, bool square, LAS unsigned char* lds) {
    int tid = threadIdx.x; asm volatile("" : "+v"(tid));
    if (tid < 256) { const f32x4* p = (const f32x4*)(ssqp + (size_t)(pm * 256 + tid) * 16);
        const f32x4 s0 = p[0], s1 = p[1], s2 = p[2], s3 = p[3];
        const float t = ((s0[0] + s0[1]) + (s0[2] + s0[3])) + ((s1[0] + s1[1]) + (s1[2] + s1[3])) + ((s2[0] + s2[1]) + (s2[2] + s2[3])) + ((s3[0] + s3[1]) + (s3[2] + s3[3]));
        const float r = 1.0f / sqrtf(t * scale_n + EPS);
        ((LAS float*)(lds + RTAB_OFF))[(ui & 1) * 256 + tid] = square ? r * r : r; }
}
struct SchedP3 { const char* A; const char* B; int G, vcu;
    DI bool next(int i, pg8::Unit& u) const { const int L = i * G + vcu; if (L >= 256) return false; u.pm = L >> 2; u.pn = L & 3; u.A = A + (size_t)u.pm * 256 * 2048; u.B = B + (size_t)u.pn * 256 * 2048; u.nt = 16; u.kind = 0; return true; } };
struct SchedP4 { const char* A; const char* B; int G, vcu;
    DI bool next(int i, pg8::Unit& u) const { const int L = i * G + vcu; if (L >= 1024) return false; u.pm = L >> 4; u.pn = L & 15; u.A = A + (size_t)u.pm * 256 * 2048; u.B = B + (size_t)u.pn * 256 * 2048; u.nt = 16; u.kind = 0; return true; } };
struct SchedP5 { const char* A; const char* B; int G, vcu;
    DI bool next(int i, pg8::Unit& u) const { const int L = i * G + vcu; if (L >= 256) return false; u.pm = L >> 2; u.pn = L & 3; u.A = A + (size_t)u.pm * 256 * 8192; u.B = B + (size_t)u.pn * 256 * 8192; u.nt = 64; u.kind = 0; return true; } };
struct SchedP6 { const char* A; const char* B; int G, vcu;
    DI bool next(int i, pg8::Unit& u) const { const int L = (i >> 1) * G + vcu; if (L >= 256) return false; u.pm = L >> 2; u.pn = L & 3; const int sub = i & 1;
        u.A = A + (size_t)u.pm * 256 * 2560 + (sub ? 0 : 2048); u.B = B + (size_t)u.pn * 256 * 2560 + (sub ? 0 : 2048); u.nt = sub ? 16 : 4; u.kind = sub; return true; } };

template <bool IS3> struct EpiRes {
    static constexpr bool HAS_MID = IS3; static constexpr int MID_T = 8;
    const float* xp; const float* xs; float* out; bf16* xbo; int ldb; float* ssqp; const float* ssqa;
    DI void a_ready(const pg8::Unit& u, int ui, LAS unsigned char* lds) const {
        if constexpr (IS3) { int tid = threadIdx.x; asm volatile("" : "+v"(tid));
            if (tid < 256) { const f32x4* p = (const f32x4*)(ssqa + (size_t)(u.pm * 256 + tid) * NH); const f32x4 s0 = p[0], s1 = p[1];
                const float t = ((s0[0] + s0[1]) + (s0[2] + s0[3])) + ((s1[0] + s1[1]) + (s1[2] + s1[3]));
                ((LAS float*)(lds + RTAB_OFF))[(ui & 1) * 256 + tid] = 1.0f / sqrtf(t * (1.f / DATT) + EPS); } }
    }
    DI void mid(f32x4 (&acc)[2][2][4][2], const pg8::Unit&, int ui, int wr, int, int fr, int, LAS unsigned char* lds) const {
        const LAS float* rt = (const LAS float*)(lds + RTAB_OFF) + (ui & 1) * 256;
#pragma unroll
        for (int ai = 0; ai < 2; ++ai)
#pragma unroll
            for (int m = 0; m < 4; ++m) { const float s = rt[ai * 128 + wr * 64 + m * 16 + fr];
#pragma unroll
                for (int bj = 0; bj < 2; ++bj)
#pragma unroll
                    for (int n = 0; n < 2; ++n) acc[ai][bj][m][n] *= s; }
    }
    DI void operator()(const f32x4 (&acc)[2][2][4][2], const pg8::Unit& u, int, int wr, int wc, int fr, int fq, LAS unsigned char*) const {
#pragma unroll
        for (int ai = 0; ai < 2; ++ai)
#pragma unroll
            for (int m = 0; m < 4; ++m) {
                const int row = u.pm * 256 + ai * 128 + wr * 64 + m * 16 + fr;
                const float* src = IS3 ? ((row < RP) ? xp + (size_t)row * DM : xs + (size_t)(row - RP) * DM) : out + (size_t)row * DM;
                float ss = 0.f;
#pragma unroll
                for (int bj = 0; bj < 2; ++bj) { const int col = u.pn * 256 + bj * 128 + wc * 32 + 8 * fq;
                    const f32x4 v0 = *(const f32x4*)(src + col) + acc[ai][bj][m][0], v1 = *(const f32x4*)(src + col + 4) + acc[ai][bj][m][1];
                    *(f32x4*)(out + (size_t)row * DM + col) = v0; *(f32x4*)(out + (size_t)row * DM + col + 4) = v1;
                    u32x4 w; w.x = cvtpk(v0[0], v0[1]); w.y = cvtpk(v0[2], v0[3]); w.z = cvtpk(v1[0], v1[1]); w.w = cvtpk(v1[2], v1[3]);
                    *(u32x4*)(xbo + (size_t)row * ldb + col) = w;
                    ss += (v0[0] * v0[0] + v0[1] * v0[1]) + (v0[2] * v0[2] + v0[3] * v0[3]) + (v1[0] * v1[0] + v1[1] * v1[1]) + (v1[2] * v1[2] + v1[3] * v1[3]); }
                ss += __shfl_xor(ss, 16); ss += __shfl_xor(ss, 32);
                if (fq == 0) ssqp[(size_t)row * 16 + u.pn * 4 + wc] = ss;
            }
    }
};
struct EpiP4 {
    static constexpr bool HAS_MID = false; static constexpr int MID_T = -1;
    const float* ssq1p; bf16* hb;
    DI void a_ready(const pg8::Unit& u, int ui, LAS unsigned char* lds) const { rtab_fill16(ssq1p, 1.f / DM, u.pm, ui, true, lds); }
    DI void mid(f32x4 (&)[2][2][4][2], const pg8::Unit&, int, int, int, int, int, LAS unsigned char*) const {}
    DI void operator()(const f32x4 (&acc)[2][2][4][2], const pg8::Unit& u, int ui, int wr, int wc, int fr, int fq, LAS unsigned char* lds) const {
        const LAS float* rt = (const LAS float*)(lds + RTAB_OFF) + (ui & 1) * 256;
#pragma unroll
        for (int ai = 0; ai < 2; ++ai)
#pragma unroll
            for (int m = 0; m < 4; ++m) { const int rl = ai * 128 + wr * 64 + m * 16 + fr; const float s2 = rt[rl];
                bf16* rowp = hb + (size_t)(u.pm * 256 + rl) * DFF + u.pn * 256 + wc * 32 + 8 * fq;
#pragma unroll
                for (int bj = 0; bj < 2; ++bj) { f32x4 v0 = acc[ai][bj][m][0], v1 = acc[ai][bj][m][1];
#pragma unroll
                    for (int e = 0; e < 4; ++e) { const float p0 = fmaxf(v0[e], 0.f), p1 = fmaxf(v1[e], 0.f); v0[e] = p0 * p0 * s2; v1[e] = p1 * p1 * s2; }
                    u32x4 w; w.x = cvtpk(v0[0], v0[1]); w.y = cvtpk(v0[2], v0[3]); w.z = cvtpk(v1[0], v1[1]); w.w = cvtpk(v1[2], v1[3]);
                    *(u32x4*)(rowp + bj * 128) = w; } }
    }
};
struct EpiP6 {
    static constexpr bool HAS_MID = false; static constexpr int MID_T = -1;
    const float* ssq2p; bf16* pleb; float* out;
    DI void a_ready(const pg8::Unit& u, int ui, LAS unsigned char* lds) const { if (u.kind == 1) rtab_fill16(ssq2p, 1.f / DM, u.pm, ui, false, lds); }
    DI void mid(f32x4 (&)[2][2][4][2], const pg8::Unit&, int, int, int, int, int, LAS unsigned char*) const {}
    DI void operator()(const f32x4 (&acc)[2][2][4][2], const pg8::Unit& u, int ui, int wr, int wc, int fr, int fq, LAS unsigned char* lds) const {
        const LAS float* rt = (const LAS float*)(lds + RTAB_OFF) + (ui & 1) * 256;
#pragma unroll
        for (int ai = 0; ai < 2; ++ai)
#pragma unroll
            for (int m = 0; m < 4; ++m) { const int rl = ai * 128 + wr * 64 + m * 16 + fr; const size_t row = (size_t)(u.pm * 256 + rl);
#pragma unroll
                for (int bj = 0; bj < 2; ++bj) { const int col = u.pn * 256 + bj * 128 + wc * 32 + 8 * fq;
                    const f32x4 v0 = acc[ai][bj][m][0], v1 = acc[ai][bj][m][1];
                    if (u.kind == 0) { u32x4 w; w.x = cvtpk(v0[0], v0[1]); w.y = cvtpk(v0[2], v0[3]); w.z = cvtpk(v1[0], v1[1]); w.w = cvtpk(v1[2], v1[3]);
                        *(u32x4*)(pleb + row * DM + col) = w; }
                    else { const float s = rt[rl];
                        const u32x4 pw = *(const u32x4*)(pleb + row * DM + col);
                        const f32x4 x0 = *(const f32x4*)(out + row * DM + col), x1 = *(const f32x4*)(out + row * DM + col + 4);
                        f32x4 o0, o1;
                        o0[0] = x0[0] + __uint_as_float(pw.x << 16) * sigmoidf_(v0[0] * s); o0[1] = x0[1] + __uint_as_float(pw.x & 0xffff0000u) * sigmoidf_(v0[1] * s);
                        o0[2] = x0[2] + __uint_as_float(pw.y << 16) * sigmoidf_(v0[2] * s); o0[3] = x0[3] + __uint_as_float(pw.y & 0xffff0000u) * sigmoidf_(v0[3] * s);
                        o1[0] = x1[0] + __uint_as_float(pw.z << 16) * sigmoidf_(v1[0] * s); o1[1] = x1[1] + __uint_as_float(pw.z & 0xffff0000u) * sigmoidf_(v1[1] * s);
                        o1[2] = x1[2] + __uint_as_float(pw.w << 16) * sigmoidf_(v1[2] * s); o1[3] = x1[3] + __uint_as_float(pw.w & 0xffff0000u) * sigmoidf_(v1[3] * s);
                        *(f32x4*)(out + row * DM + col) = o0; *(f32x4*)(out + row * DM + col + 4) = o1; } } }
    }
};


template <int NF, int NKS, int KB>
DI void mini_mma(f32x4 (&acc)[4][NF], const bf16* A, int lda, const bf16* B, int ldb, int fr, int fq) {
    const bf16* ap = A + (size_t)fr * lda + 8 * fq; const bf16* bp = B + (size_t)fr * ldb + 8 * fq;
#pragma unroll 1
    for (int kb = 0; kb < NKS; kb += KB) {
        bf16x8 af[KB][4], bfr[KB][NF];
#pragma unroll
        for (int k = 0; k < KB; ++k) {
#pragma unroll
            for (int m = 0; m < 4; ++m) af[k][m] = *(const bf16x8*)(ap + (size_t)(16 * m) * lda + 32 * (kb + k));
#pragma unroll
            for (int n = 0; n < NF; ++n) bfr[k][n] = *(const bf16x8*)(bp + (size_t)(16 * n) * ldb + 32 * (kb + k)); }
#pragma unroll
        for (int k = 0; k < KB; ++k)
#pragma unroll
            for (int m = 0; m < 4; ++m)
#pragma unroll
                for (int n = 0; n < NF; ++n) acc[m][n] = __builtin_amdgcn_mfma_f32_16x16x32_bf16(bfr[k][n], af[k][m], acc[m][n], 0, 0, 0);
    }
}
template <int NF> DI void mini_zero(f32x4 (&acc)[4][NF]) {
#pragma unroll
    for (int m = 0; m < 4; ++m)
#pragma unroll
        for (int n = 0; n < NF; ++n) acc[m][n] = (f32x4){0.f, 0.f, 0.f, 0.f};
}
template <int NF> DI void mini_put(const f32x4 (&acc)[4][NF], LAS unsigned char* lds, int off, int wave, int lane) {
#pragma unroll
    for (int m = 0; m < 4; ++m)
#pragma unroll
        for (int n = 0; n < NF; ++n) *(LAS f32x4*)(lds + off + ((wave * 4 * NF + m * NF + n) * 64 + lane) * 16) = acc[m][n];
}
template <int NF> DI f32x4 mini_get(LAS unsigned char* lds, int off, int frag, int lane, int w0, int w1) {
    f32x4 v = (f32x4){0.f, 0.f, 0.f, 0.f};
    for (int w = w0; w < w1; ++w) v += *(const LAS f32x4*)(lds + off + ((w * 4 * NF + frag) * 64 + lane) * 16);
    return v;
}
DI void mini_rtab(const float* ssqs, int rg, bool square, LAS unsigned char* lds, int tid) {
    const int row = tid >> 3, part = tid & 7;
    const f32x4* p = (const f32x4*)(ssqs + (size_t)(64 * rg + row) * 64 + 8 * part);
    const f32x4 s0 = p[0], s1 = p[1];
    float t = ((s0[0] + s0[1]) + (s0[2] + s0[3])) + ((s1[0] + s1[1]) + (s1[2] + s1[3]));
    t += __shfl_xor(t, 1); t += __shfl_xor(t, 2); t += __shfl_xor(t, 4);
    const float r = 1.0f / sqrtf(t * (1.f / DM) + EPS);
    if (part == 0) ((LAS float*)(lds + RTAB_OFF))[row] = square ? r * r : r;
    __syncthreads();
}
DI void piece_p3(const Args& a, LAS unsigned char* lds, int p, int tid, int wave, int lane) {
    asm volatile("" : "+v"(tid), "+v"(lane));
    unsigned char* ws = a.ws; const int rg = p >> 5, cg = p & 31, fr = lane & 15, fq = lane >> 4;
    f32x4 acc[4][2]; mini_zero<2>(acc);
    mini_mma<2, 4, 4>(acc, (const bf16*)(ws + WS_MRG) + (size_t)(RP + 64 * rg) * DM + 128 * wave, DM, (const bf16*)(ws + WS_WOUT) + (size_t)(32 * cg) * DM + 128 * wave, DM, fr, fq);
    mini_put<2>(acc, lds, 0, wave, lane);
    __syncthreads();
    { const int m = wave >> 1, n = wave & 1, rl = 64 * rg + 16 * m + fr, row = RP + rl, col = 32 * cg + 16 * n + 4 * fq;
      const f32x4* sp = (const f32x4*)((const float*)(ws + WS_SSQA) + (size_t)row * NH); const f32x4 s0 = sp[0], s1 = sp[1];
      const float ra = 1.0f / sqrtf((((s0[0] + s0[1]) + (s0[2] + s0[3])) + ((s1[0] + s1[1]) + (s1[2] + s1[3]))) * (1.f / DATT) + EPS);
      const f32x4 v = mini_get<2>(lds, 0, wave, lane, 0, 4) * ra + mini_get<2>(lds, 0, wave, lane, 4, 8);
      const f32x4 x1 = *(const f32x4*)(a.in[1] + (size_t)rl * DM + col) + v;
      *(f32x4*)(a.out + (size_t)row * DM + col) = x1;
      u32x2 w; w.x = cvtpk(x1[0], x1[1]); w.y = cvtpk(x1[2], x1[3]); *(u32x2*)((bf16*)(ws + WS_X1B) + (size_t)row * DM + col) = w;
      float ss = (x1[0] * x1[0] + x1[1] * x1[1]) + (x1[2] * x1[2] + x1[3] * x1[3]); ss += __shfl_xor(ss, 16); ss += __shfl_xor(ss, 32);
      if (fq == 0) ((float*)(ws + WS_SSQS1))[(size_t)rl * 64 + 2 * cg + n] = ss; }
    __syncthreads();
}
DI void piece_p4(const Args& a, LAS unsigned char* lds, int p, int tid, int wave, int lane) {
    asm volatile("" : "+v"(tid), "+v"(lane));
    unsigned char* ws = a.ws; const int rg = p >> 5, cg = p & 31, fr = lane & 15, fq = lane >> 4;
    mini_rtab((const float*)(ws + WS_SSQS1), rg, true, lds, tid);
#pragma unroll 1
    for (int half = 0; half < 2; ++half) {
        f32x4 acc[4][4]; mini_zero<4>(acc);
        mini_mma<4, 4, 2>(acc, (const bf16*)(ws + WS_X1B) + (size_t)(RP + 64 * rg) * DM + 128 * wave, DM, (const bf16*)(ws + WS_W1) + (size_t)(128 * cg + 64 * half) * DM + 128 * wave, DM, fr, fq);
        mini_put<4>(acc, lds, 0, wave, lane);
        __syncthreads();
#pragma unroll
        for (int q = 0; q < 2; ++q) { const int f = 2 * wave + q, m = f >> 2, n = f & 3, rl = 16 * m + fr;
            f32x4 v = mini_get<4>(lds, 0, f, lane, 0, 8); const float s2 = ((const LAS float*)(lds + RTAB_OFF))[rl];
#pragma unroll
            for (int e = 0; e < 4; ++e) { const float t = fmaxf(v[e], 0.f); v[e] = t * t * s2; }
            u32x2 w; w.x = cvtpk(v[0], v[1]); w.y = cvtpk(v[2], v[3]);
            *(u32x2*)((bf16*)(ws + WS_H) + (size_t)(RP + 64 * rg + rl) * DFF + 128 * cg + 64 * half + 16 * n + 4 * fq) = w; }
        __syncthreads();
    }
}
DI void piece_p5(const Args& a, LAS unsigned char* lds, int p, int tid, int wave, int lane) {
    asm volatile("" : "+v"(tid), "+v"(lane));
    unsigned char* ws = a.ws; const int rg = p >> 5, cg = p & 31, fr = lane & 15, fq = lane >> 4;
    f32x4 acc[4][2]; mini_zero<2>(acc);
    mini_mma<2, 16, 4>(acc, (const bf16*)(ws + WS_H) + (size_t)(RP + 64 * rg) * DFF + 512 * wave, DFF, (const bf16*)(ws + WS_W2) + (size_t)(32 * cg) * DFF + 512 * wave, DFF, fr, fq);
    mini_put<2>(acc, lds, 0, wave, lane);
    __syncthreads();
    { const int m = wave >> 1, n = wave & 1, rl = 64 * rg + 16 * m + fr, row = RP + rl, col = 32 * cg + 16 * n + 4 * fq;
      const f32x4 v = mini_get<2>(lds, 0, wave, lane, 0, 8);
      const f32x4 x2 = *(const f32x4*)(a.out + (size_t)row * DM + col) + v;
      *(f32x4*)(a.out + (size_t)row * DM + col) = x2;
      u32x2 w; w.x = cvtpk(x2[0], x2[1]); w.y = cvtpk(x2[2], x2[3]); *(u32x2*)((bf16*)(ws + WS_ACAT) + (size_t)row * 1280 + col) = w;
      float ss = (x2[0] * x2[0] + x2[1] * x2[1]) + (x2[2] * x2[2] + x2[3] * x2[3]); ss += __shfl_xor(ss, 16); ss += __shfl_xor(ss, 32);
      if (fq == 0) ((float*)(ws + WS_SSQS2))[(size_t)rl * 64 + 2 * cg + n] = ss; }
    __syncthreads();
}
DI void piece_p6(const Args& a, LAS unsigned char* lds, int p, int tid, int wave, int lane) {
    asm volatile("" : "+v"(tid), "+v"(lane));
    unsigned char* ws = a.ws; const int rg = p >> 5, cg = p & 31, fr = lane & 15, fq = lane >> 4;
    mini_rtab((const float*)(ws + WS_SSQS2), rg, false, lds, tid);
    const bf16* A = (const bf16*)(ws + WS_ACAT) + (size_t)(RP + 64 * rg) * 1280; const bf16* B = (const bf16*)(ws + WS_WGP) + (size_t)(32 * cg) * 1280;
    { f32x4 acc[4][2]; mini_zero<2>(acc); mini_mma<2, 4, 4>(acc, A + 128 * wave, 1280, B + 128 * wave, 1280, fr, fq); mini_put<2>(acc, lds, 0, wave, lane); }
    { f32x4 acc[4][2]; mini_zero<2>(acc); mini_mma<2, 1, 1>(acc, A + 1024 + 32 * wave, 1280, B + 1024 + 32 * wave, 1280, fr, fq); mini_put<2>(acc, lds, 65536, wave, lane); }
    __syncthreads();
    { const int m = wave >> 1, n = wave & 1, rl = 16 * m + fr, row = RP + 64 * rg + rl, col = 32 * cg + 16 * n + 4 * fq;
      const f32x4 g = mini_get<2>(lds, 0, wave, lane, 0, 8), pl = mini_get<2>(lds, 65536, wave, lane, 0, 8); const float s = ((const LAS float*)(lds + RTAB_OFF))[rl];
      f32x4 o = *(const f32x4*)(a.out + (size_t)row * DM + col);
#pragma unroll
      for (int e = 0; e < 4; ++e) o[e] += pl[e] * sigmoidf_(g[e] * s);
      *(f32x4*)(a.out + (size_t)row * DM + col) = o; }
    __syncthreads();
}

__global__ void __launch_bounds__(512, 2) fwd_kernel(Args args) {
    extern __shared__ __attribute__((aligned(16))) unsigned char lds_raw[];
    LAS unsigned char* lds = (LAS unsigned char*)lds_raw;
    volatile LAS unsigned* MISC = (volatile LAS unsigned*)(lds + MISC_OFF);
    const int tid = threadIdx.x, lane = tid & 63, wave = __builtin_amdgcn_readfirstlane(tid >> 6);
    const int G = gridDim.x; const int bx = blockIdx.x; const int vcu = (G % 8 == 0) ? (bx % 8) * (G / 8) + bx / 8 : bx;
    unsigned char* ws = args.ws;
    gu32* ctl = (gu32*)(ws + WS_CTL);
    for (int u = tid; u < (LDS_BYTES - RING_BYTES) / 4; u += 512) ((LAS unsigned*)(lds + RING_BYTES))[u] = 0u;
    __syncthreads();
    XcdBarrier bar = xcd_barrier_post((unsigned*)(ctl + CW_BAR), MISC + 8);

    p0_prep(args, lds, vcu, G, wave, lane);
    xcd_barrier(bar);
    {
        SchedP1 S{(const char*)(ws + WS_XB), (const char*)(ws + WS_WIN), G, vcu};
        EpiP1 E{(const float*)(ws + WS_RMIX), (bf16*)(ws + WS_UB), (bf16*)(ws + WS_QB), (bf16*)(ws + WS_KB), (bf16*)(ws + WS_VTP), (bf16*)(ws + WS_VTS), args.out, args.in[13], args.in[14]};
        pg8::gemm_phase<EpiP1, SchedP1, true>(lds, 1024, S, E);
    }
    xcd_barrier(bar);
    for (int it = vcu; it < 1056; it += G) {
        if (it < 528) attn_unit(args, lds, it >> 1, it & 1, tid, wave, lane);
        else conv_item(args, lds, it - 528, tid, wave, lane);
    }
    xcd_barrier(bar);
    for (int p = vcu; p < 256; p += G) piece_p3(args, lds, p, tid, wave, lane);
    {
        SchedP3 S{(const char*)(ws + WS_MRG), (const char*)(ws + WS_WOUT), G, vcu};
        EpiRes<true> E{args.in[0], args.in[1], args.out, (bf16*)(ws + WS_X1B), DM, (float*)(ws + WS_SSQ1), (const float*)(ws + WS_SSQA)};
        pg8::gemm_phase<EpiRes<true>, SchedP3, true>(lds, 1024, S, E);
    }
    xcd_barrier(bar);
    for (int p = vcu; p < 256; p += G) piece_p4(args, lds, p, tid, wave, lane);
    {
        SchedP4 S{(const char*)(ws + WS_X1B), (const char*)(ws + WS_W1), G, vcu};
        EpiP4 E{(const float*)(ws + WS_SSQ1), (bf16*)(ws + WS_H)};
        pg8::gemm_phase<EpiP4, SchedP4, true>(lds, 1024, S, E);
    }
    xcd_barrier(bar);
    for (int p = vcu; p < 256; p += G) piece_p5(args, lds, p, tid, wave, lane);
    {
        SchedP5 S{(const char*)(ws + WS_H), (const char*)(ws + WS_W2), G, vcu};
        EpiRes<false> E{nullptr, nullptr, args.out, (bf16*)(ws + WS_ACAT), 1280, (float*)(ws + WS_SSQ2), nullptr};
        pg8::gemm_phase<EpiRes<false>, SchedP5, true>(lds, 4096, S, E);
    }
    xcd_barrier(bar);
    for (int p = vcu; p < 256; p += G) piece_p6(args, lds, p, tid, wave, lane);
    {
        SchedP6 S{(const char*)(ws + WS_ACAT), (const char*)(ws + WS_WGP), G, vcu};
        EpiP6 E{(const float*)(ws + WS_SSQ2), (bf16*)(ws + WS_PLE), args.out};
        pg8::gemm_phase<EpiP6, SchedP6, true>(lds, 1280, S, E);
    }
}

extern "C" void kernel_launch(void* const* d_in, const int* in_sizes, int n_in, void* d_out, int out_size, void* d_ws, size_t ws_size, hipStream_t stream) {
    static int grid = 0;
    if (grid == 0) {
        if (n_in != 25 || in_sizes[0] != RP * DM || (size_t)out_size != O_END || ws_size < WS_END) {
            fprintf(stderr, "kernel_launch: unexpected shapes: n_in %d in0 %d out %d ws %zu; nothing launched\n", n_in, n_in > 0 ? in_sizes[0] : -1, out_size, ws_size); grid = -1; return; }
        int dev = 0, cus = 0, per_cu = 0;
        if (hipGetDevice(&dev) != hipSuccess || hipDeviceGetAttribute(&cus, hipDeviceAttributeMultiprocessorCount, dev) != hipSuccess) { grid = -1; return; }
        if (hipFuncSetAttribute((const void*)fwd_kernel, hipFuncAttributeMaxDynamicSharedMemorySize, LDS_BYTES) != hipSuccess) { fprintf(stderr, "kernel_launch: hipFuncSetAttribute failed\n"); grid = -1; return; }
        if (hipOccupancyMaxActiveBlocksPerMultiprocessor(&per_cu, (const void*)fwd_kernel, 512, LDS_BYTES) != hipSuccess || per_cu < 1)
            fprintf(stderr, "kernel_launch: note: occupancy query reports %d workgroups per CU\n", per_cu);
        (void)hipGetLastError();
        grid = cus;
    }
    if (grid < 0) return;
    if (hipMemsetAsync((char*)d_ws + WS_CTL, 0, CTL_ZERO_BYTES, stream) != hipSuccess) return;
    Args a{};
    for (int i = 0; i < 25; ++i) a.in[i] = (const float*)d_in[i];
    a.out = (float*)d_out; a.ws = (unsigned char*)d_ws;
    hipLaunchKernelGGL(fwd_kernel, dim3(grid), dim3(512), LDS_BYTES, stream, a);
}
```
